# Optimizing an MI355X kernel written in HIP

```python
import jax, jax.numpy as jnp
from jax import lax
import numpy as np

D_MODEL = 1024
BATCH = 2
SEQ = 16384
DEPTH = 2

HGRN_WIDTH = D_MODEL // 2
HGRN_EXPAND = 128
HGRN_HEADS = HGRN_WIDTH // HGRN_EXPAND
HGRN_DK = HGRN_EXPAND
HGRN_DV = HGRN_WIDTH // HGRN_HEADS
HGRN_CHUNK = 64
ATTN_WIDTH = D_MODEL - HGRN_WIDTH
ATTN_HEADS = 8
ATTN_DH = ATTN_WIDTH // ATTN_HEADS
DILATED_PATTERNS = ((128, 1), (512, 4), (2048, 16))
D_FF = 4 * D_MODEL
IN_SIZES = (HGRN_WIDTH, HGRN_WIDTH, HGRN_WIDTH, HGRN_WIDTH, ATTN_WIDTH, ATTN_WIDTH, ATTN_WIDTH)
IN_COLS = sum(IN_SIZES)
IN_SPLITS = tuple(int(c) for c in np.cumsum(IN_SIZES)[:-1])
DEEPNORM_ALPHA = (2 * DEPTH) ** 0.25
DEEPNORM_BETA = (8 * DEPTH) ** -0.25
LN_EPS = 1e-5
RMS_EPS = 1e-6

kernel_name = "hymba_style_hgrn2_dilated_attn_deepnorm"


def layer_norm(x, g, b):
    xf = x.astype(jnp.float32)
    mu = jnp.mean(xf, axis=-1, keepdims=True)
    var = jnp.mean(jnp.square(xf - mu), axis=-1, keepdims=True)
    y = (xf - mu) * lax.rsqrt(var + LN_EPS) * g.astype(jnp.float32) + b.astype(jnp.float32)
    return y.astype(x.dtype)


def hgrn2_mixer(q, f_logit, i, gate, lb, norm_w):
    B, S, _ = q.shape
    H, dk, dv, C = HGRN_HEADS, HGRN_DK, HGRN_DV, HGRN_CHUNK
    nc = S // C
    f32 = jnp.float32
    q = jax.nn.silu(q.astype(f32))
    lb = lb.astype(f32)
    log_f = jnp.logaddexp(jnp.log(lb), jnp.log1p(-lb) + jax.nn.log_sigmoid(f_logit.astype(f32)))
    k = -jnp.expm1(log_f)
    v = i.astype(f32)

    def to_chunks(t, d):
        return t.reshape(B, nc, C, H, d).transpose(1, 0, 3, 2, 4)

    tri = jnp.tril(jnp.ones((C, C), dtype=bool))[:, :, None]

    def step(state, inp):
        qc, kc, vc, gc = inp
        G = jnp.cumsum(gc, axis=2)
        o_inter = jnp.einsum('bhtk,bhkv->bhtv', qc * jnp.exp(G), state)
        diff = G[:, :, :, None, :] - G[:, :, None, :, :]
        decay = jnp.exp(jnp.where(tri, diff, -jnp.inf))
        scores = jnp.einsum('bhtk,bhsk,bhtsk->bhts', qc, kc, decay)
        o_intra = jnp.einsum('bhts,bhsv->bhtv', scores, vc)
        G_last = G[:, :, -1:, :]
        k_dec = kc * jnp.exp(G_last - G)
        new_state = jnp.exp(G_last[:, :, 0, :])[..., None] * state + jnp.einsum('bhsk,bhsv->bhkv', k_dec, vc)
        return new_state, o_inter + o_intra

    state0 = jnp.zeros((B, H, dk, dv), f32)
    _, o = lax.scan(step, state0, (to_chunks(q, dk), to_chunks(k, dk), to_chunks(v, dv), to_chunks(log_f, dk)))
    o = o.transpose(1, 0, 3, 2, 4).reshape(B, S, H, dv)
    o = o * lax.rsqrt(jnp.mean(o * o, axis=-1, keepdims=True) + RMS_EPS) * norm_w.astype(f32).reshape(H, dv)
    return o.reshape(B, S, H * dv) * jax.nn.sigmoid(gate.astype(f32))


def dilated_branch(q, k, v, window, dilation):
    B, S, H, dh = q.shape
    L = S // dilation
    blk = window // dilation
    nb = -(-L // blk)
    Lp = nb * blk

    def sub(t):
        t = t.reshape(B, L, dilation, H, dh).transpose(0, 3, 2, 1, 4)
        t = jnp.pad(t, ((0, 0), (0, 0), (0, 0), (0, Lp - L), (0, 0)))
        return t.reshape(B, H, dilation, nb, blk, dh)

    qb, kb, vb = sub(q), sub(k), sub(v)

    def with_prev(t):
        prev = jnp.pad(t, ((0, 0), (0, 0), (0, 0), (1, 0), (0, 0), (0, 0)))[:, :, :, :-1]
        return jnp.concatenate([prev, t], axis=4)

    kc, vc = with_prev(kb), with_prev(vb)
    s = jnp.einsum('bhrnqd,bhrnkd->bhrnqk', qb, kc)
    qpos = jnp.arange(blk)[:, None] + blk
    kpos = jnp.arange(2 * blk)[None, :]
    dist = qpos - kpos
    band = (dist >= 0) & (dist <= blk)
    first_ok = (jnp.arange(nb)[:, None, None] > 0) | (kpos[None] >= blk)
    mask = band[None] & first_ok
    s = jnp.where(mask, s, -jnp.inf)
    m = jnp.max(s, axis=-1, keepdims=True)
    p = jnp.exp(s - m)
    denom = jnp.sum(p, axis=-1, keepdims=True)
    o = jnp.einsum('bhrnqk,bhrnkd->bhrnqd', p, vc) / denom

    def unsub(t):
        c = t.shape[-1]
        t = t.reshape(B, H, dilation, Lp, c)[:, :, :, :L]
        return t.transpose(0, 3, 2, 1, 4).reshape(B, S, H, c)

    return unsub(o), unsub(m), unsub(denom)


def dilated_attention(q, k, v):
    B, S, _ = q.shape
    f32 = jnp.float32
    q = q.astype(f32).reshape(B, S, ATTN_HEADS, ATTN_DH) * (ATTN_DH ** -0.5)
    k = k.astype(f32).reshape(B, S, ATTN_HEADS, ATTN_DH)
    v = v.astype(f32).reshape(B, S, ATTN_HEADS, ATTN_DH)
    branches = [dilated_branch(q, k, v, w, d) for (w, d) in DILATED_PATTERNS]
    m_all = jnp.max(jnp.stack([b[1] for b in branches]), axis=0)
    weights = [b[2] * jnp.exp(b[1] - m_all) for b in branches]
    num = sum(wt * b[0] for wt, b in zip(weights, branches))
    o = num / sum(weights)
    return o.reshape(B, S, ATTN_WIDTH)


def hybrid_mixer(x, w_in, w_out, lb, hgrn_norm_w):
    proj = jnp.einsum('bsd,dn->bsn', x, w_in)
    hq, hf, hi, hg, aq, ak, av = jnp.split(proj, IN_SPLITS, axis=-1)
    o_rec = hgrn2_mixer(hq, hf, hi, hg, lb, hgrn_norm_w)
    o_att = dilated_attention(aq, ak, av)
    o = jnp.concatenate([o_rec, o_att], axis=-1).astype(x.dtype)
    return jnp.einsum('bsn,nd->bsd', o, w_out)


def sq_relu_mlp(x, w1, w2):
    h = jnp.square(jax.nn.relu(jnp.einsum('bsd,df->bsf', x, w1)))
    return jnp.einsum('bsf,fd->bsd', h, w2)


def setup_inputs(seed: int = 0) -> dict:
    key = jax.random.key(seed)
    ks = jax.random.split(key, 12)
    f32 = jnp.float32
    x = jax.random.normal(ks[0], (BATCH, SEQ, D_MODEL), f32)
    w_in = jax.random.normal(ks[1], (DEPTH, D_MODEL, IN_COLS), f32) * D_MODEL ** -0.5
    w_out = jax.random.normal(ks[2], (DEPTH, D_MODEL, D_MODEL), f32) * (D_MODEL ** -0.5 * DEEPNORM_BETA)
    lower_bounds = 0.1 * jax.random.normal(ks[3], (DEPTH, HGRN_WIDTH), f32)
    hgrn_norm_w = 1.0 + 0.02 * jax.random.normal(ks[4], (DEPTH, HGRN_WIDTH), f32)
    ln1_g = 1.0 + 0.02 * jax.random.normal(ks[5], (DEPTH, D_MODEL), f32)
    ln1_b = 0.02 * jax.random.normal(ks[6], (DEPTH, D_MODEL), f32)
    w_ff1 = jax.random.normal(ks[7], (DEPTH, D_MODEL, D_FF), f32) * D_MODEL ** -0.5
    w_ff2 = jax.random.normal(ks[8], (DEPTH, D_FF, D_MODEL), f32) * (D_FF ** -0.5 * DEEPNORM_BETA)
    ln2_g = 1.0 + 0.02 * jax.random.normal(ks[9], (DEPTH, D_MODEL), f32)
    ln2_b = 0.02 * jax.random.normal(ks[10], (DEPTH, D_MODEL), f32)
    return {"x": x, "w_in": w_in, "w_out": w_out, "lower_bounds": lower_bounds,
            "hgrn_norm_w": hgrn_norm_w, "ln1_g": ln1_g, "ln1_b": ln1_b,
            "w_ff1": w_ff1, "w_ff2": w_ff2, "ln2_g": ln2_g, "ln2_b": ln2_b}


def reference(x, w_in, w_out, lower_bounds, hgrn_norm_w, ln1_g, ln1_b, w_ff1, w_ff2, ln2_g, ln2_b):
    lbs = jnp.cumsum(jax.nn.softmax(lower_bounds.astype(jnp.float32), axis=0), axis=0)
    lbs = lbs - lbs[0:1]
    for l in range(DEPTH):
        y = hybrid_mixer(x, w_in[l], w_out[l], lbs[l], hgrn_norm_w[l])
        x = layer_norm(DEEPNORM_ALPHA * x + y, ln1_g[l], ln1_b[l])
        y = sq_relu_mlp(x, w_ff1[l], w_ff2[l])
        x = layer_norm(DEEPNORM_ALPHA * x + y, ln2_g[l], ln2_b[l])
    return x
```

```cpp
#include <hip/hip_runtime.h>
#include <cstdio>
#include <cstdint>
namespace pg8 {
#define PG8_LAS __attribute__((address_space(3)))
typedef unsigned short bf16_t;
typedef short bf16x8 __attribute__((ext_vector_type(8)));
typedef float f32x4 __attribute__((ext_vector_type(4)));
typedef unsigned u32x4 __attribute__((ext_vector_type(4)));
constexpr int BM = 256, BK = 64, HALF = 128, HTB = HALF * BK * 2  , STAGE_BYTES = 8 * HTB, NXCD = 8, WGM = 8;

__host__ __device__ __forceinline__ int lds_byte(int r, int c) { const int st = (r >> 4) * 2 + (c >> 5), rr = r & 15, cc = c & 31, ob = rr * 64 + cc * 2; return st * 1024 + (ob ^ (((ob >> 9) & 1) << 5)); }
__host__ __device__ __forceinline__ void stage_rc(int b, int& R, int& C) { const int st = b / 1024, sb = b % 1024, swz = sb ^ (((sb >> 9) & 1) << 5); R = (st >> 1) * 16 + swz / 64; C = (st & 1) * 32 + (swz % 64) / 2; }
__host__ __device__ __forceinline__ int perm32(int rho) { const int n = rho >> 4, i = rho & 15; return 8 * (i >> 2) + 4 * n + (i & 3); }

struct Unit { int pm, pn; };
struct Gemm { const bf16_t* A; const bf16_t* Bt; int M, N, K; };

struct StaticOrder {
    int nM, nN, nwg, G, c;
    __host__ __device__ void init(int M, int N, int G_, int c_) { nM = M / BM; nN = N / BM; nwg = nM * nN; G = G_; c = c_; }
    __host__ __device__ bool next(int i, Unit& u) const {
        const long L = (long)i * G + c; if (L >= nwg) return false;
        int wgid = (int)L; { const int q = nwg / NXCD, r = nwg % NXCD, xcd = wgid % NXCD, off = wgid / NXCD; wgid = (xcd < r ? xcd * (q + 1) : r * (q + 1) + (xcd - r) * q) + off; }
        const int nig = WGM * nN, gid = wgid / nig, fm = gid * WGM, gsz = (nM - fm) < WGM ? (nM - fm) : WGM;
        u.pm = fm + ((wgid % nig) % gsz); u.pn = (wgid % nig) / gsz; return true;
    }
    __device__ __forceinline__ void a_ready(const Unit&) const {}
    __device__ __forceinline__ void done(const Unit&) const {}
};

__device__ __forceinline__ unsigned cvt_pk_bf16(float lo, float hi) { unsigned r; asm volatile("v_cvt_pk_bf16_f32 %0, %1, %2" : "=v"(r) : "v"(lo), "v"(hi)); return r; }
typedef float f32x2 __attribute__((ext_vector_type(2)));
__device__ __forceinline__ f32x2 gelu_pk(f32x2 v) {
    const f32x2 av = __builtin_elementwise_abs(v), d = av * 0.2316418882f + 1.0f;
    f32x2 t; t.x = __builtin_amdgcn_rcpf(d.x); t.y = __builtin_amdgcn_rcpf(d.y);
    f32x2 q = t * 0.5307027145f + (-0.7265760135f); q = q * t + 0.7107068705f; q = q * t + (-0.142248368f); q = q * t + 0.127414796f; q = q * t;
    const f32x2 s = (v * v) * (-0.72134752044f);
    f32x2 e; e.x = __builtin_amdgcn_exp2f(s.x); e.y = __builtin_amdgcn_exp2f(s.y);
    const f32x2 m = v * (q * e), r = v - m;
    f32x2 o; o.x = v.x < 0.f ? m.x : r.x; o.y = v.y < 0.f ? m.y : r.y; return o;
}

template <int ACT  > struct EpiBf16 {
    static constexpr bool PERM = true, AFTER_DRAIN = false; static_assert(ACT == 0 || ACT == 1, "EpiBf16: ACT is 0 (none) or 1 (gelu_pk)");
    bf16_t* O; int ldc; const float* bias; int split_cols; size_t split_stride; float scale0;
    __device__ __forceinline__ void operator()(const f32x4 (&acc)[2][2][4][2], const Unit& u, int wr, int wc, int fr, int fq) const {
        const int row0 = u.pm * BM + wr * 64 + fr; int colt = u.pn * BM; bf16_t* base = O;
        float sc = 1.f; if (split_cols) { const int t = colt / split_cols; base += (size_t)t * split_stride; colt -= t * split_cols; if (t == 0) sc = scale0; }
        const int col0 = colt + wc * 32 + 8 * fq, bcol0 = u.pn * BM + wc * 32 + 8 * fq;
        f32x4 bv[2][2];
#pragma unroll
        for (int bj = 0; bj < 2; ++bj)
#pragma unroll
            for (int n = 0; n < 2; ++n) bv[bj][n] = bias ? *(const f32x4*)(bias + bcol0 + bj * HALF + 4 * n) : (f32x4){0.f, 0.f, 0.f, 0.f};
#pragma unroll
        for (int ai = 0; ai < 2; ++ai)
#pragma unroll
            for (int m = 0; m < 4; ++m) { bf16_t* rowp = base + (size_t)(row0 + ai * HALF + m * 16) * ldc + col0;
#pragma unroll
                for (int bj = 0; bj < 2; ++bj) { f32x4 v0 = acc[ai][bj][m][0] + bv[bj][0], v1 = acc[ai][bj][m][1] + bv[bj][1];
                    if (ACT == 1) { f32x2 a = gelu_pk((f32x2){v0[0], v0[1]}), b = gelu_pk((f32x2){v0[2], v0[3]}), c = gelu_pk((f32x2){v1[0], v1[1]}), d = gelu_pk((f32x2){v1[2], v1[3]});
                        v0 = (f32x4){a.x, a.y, b.x, b.y}; v1 = (f32x4){c.x, c.y, d.x, d.y}; }
                    v0 = v0 * sc; v1 = v1 * sc; u32x4 w; w.x = cvt_pk_bf16(v0[0], v0[1]); w.y = cvt_pk_bf16(v0[2], v0[3]); w.z = cvt_pk_bf16(v1[0], v1[1]); w.w = cvt_pk_bf16(v1[2], v1[3]);
                    *(u32x4*)(rowp + bj * HALF) = w; } }
    }
};

struct PanelStats {
    unsigned* xbuf;
    unsigned* cnt;
    unsigned* tmo;
    int ntn; float eps;
    unsigned code;
    __device__ __forceinline__ bool run(const f32x4 (&v)[2][2][4][2], const Unit& u, int wr, int wc, int fr, int fq, PG8_LAS unsigned char* lds, int wid, int lane) const {
        typedef float f32x2v __attribute__((ext_vector_type(2)));
        PG8_LAS f32x2v* P = (PG8_LAS f32x2v*)lds;
        PG8_LAS f32x2v* S = (PG8_LAS f32x2v*)(lds + 8192);
        PG8_LAS unsigned* flag = (PG8_LAS unsigned*)(lds + 8192 + 2048);
#pragma unroll
        for (int ai = 0; ai < 2; ++ai)
#pragma unroll
            for (int m = 0; m < 4; ++m) {
                float s = 0.f;
#pragma unroll
                for (int bj = 0; bj < 2; ++bj)
#pragma unroll
                    for (int n = 0; n < 2; ++n) { const f32x4 x = v[ai][bj][m][n]; s += (x[0] + x[1]) + (x[2] + x[3]); }
                s += __shfl_xor(s, 16); s += __shfl_xor(s, 32);
                const float mw = s * (1.0f / 64.0f); float q = 0.f;
#pragma unroll
                for (int bj = 0; bj < 2; ++bj)
#pragma unroll
                    for (int n = 0; n < 2; ++n) { const f32x4 d = v[ai][bj][m][n] - mw; q += (d[0] * d[0] + d[1] * d[1]) + (d[2] * d[2] + d[3] * d[3]); }
                q += __shfl_xor(q, 16); q += __shfl_xor(q, 32);
                if (fq == 0) P[(ai * HALF + wr * 64 + m * 16 + fr) * 4 + wc] = (f32x2v){mw, q};
            }
        asm volatile("s_waitcnt lgkmcnt(0)" ::: "memory"); __builtin_amdgcn_s_barrier(); asm volatile("" ::: "memory");
#if defined(BROKEN_EXCHANGE_NO_WAIT)
#warning BROKEN CONTROL BUILD: the row-statistics exchange does not wait; results are wrong by design
        if (blockIdx.x >= 64) { const long long t0_ = clock64(); while (clock64() - t0_ < 60000) __builtin_amdgcn_s_sleep(8); }
#endif
        const int row = wid * 32 + (lane & 31);
        if (lane < 32) {
            const f32x2v a = P[row * 4 + 0], b = P[row * 4 + 1], c = P[row * 4 + 2], d = P[row * 4 + 3];
            const float mt = (a.x + b.x + c.x + d.x) * 0.25f;
            const float da = a.x - mt, db = b.x - mt, dc = c.x - mt, dd = d.x - mt;
            const float m2 = (a.y + b.y) + (c.y + d.y) + 64.0f * ((da * da + db * db) + (dc * dc + dd * dd));
            unsigned long long* slot = (unsigned long long*)xbuf + ((size_t)(u.pm * BM + row) * 4 + u.pn);
            __hip_atomic_store(slot, ((unsigned long long)__float_as_uint(m2) << 32) | __float_as_uint(mt), __ATOMIC_RELAXED, __HIP_MEMORY_SCOPE_AGENT);
        }
        asm volatile("s_waitcnt vmcnt(0)" ::: "memory");
        if (lane == 0) __hip_atomic_fetch_add(cnt + 64 * u.pm, 1u, __ATOMIC_RELAXED, __HIP_MEMORY_SCOPE_AGENT);
        if (wid == 0) {
            bool dead = false; const unsigned long long t0 = __builtin_amdgcn_s_memrealtime(); const unsigned want = 8u * (unsigned)ntn;
            for (;;) {
#if defined(BROKEN_EXCHANGE_NO_WAIT)
                break;
#endif
                if ((unsigned)__builtin_amdgcn_readfirstlane(__hip_atomic_load(cnt + 64 * u.pm, __ATOMIC_RELAXED, __HIP_MEMORY_SCOPE_AGENT)) >= want) break;
                if (__builtin_amdgcn_s_memrealtime() - t0 > 2000000ull) {
                    if (lane == 0) { unsigned expect = 0u; __hip_atomic_compare_exchange_strong(tmo + 1, &expect, code | (unsigned)(u.pm & 0xff), __ATOMIC_RELAXED, __ATOMIC_RELAXED, __HIP_MEMORY_SCOPE_AGENT);
                                     __hip_atomic_store(tmo, 1u, __ATOMIC_RELAXED, __HIP_MEMORY_SCOPE_AGENT); }
                    dead = true; break; }
                __builtin_amdgcn_s_sleep(2);
            }
            __builtin_amdgcn_fence(__ATOMIC_ACQUIRE, "agent");
            if (lane == 0) flag[0] = dead ? 1u : 0u;
        }
        asm volatile("s_waitcnt vmcnt(0) lgkmcnt(0)" ::: "memory"); __builtin_amdgcn_s_barrier(); asm volatile("" ::: "memory");
        const bool bad = flag[0] != 0u;
        if (lane < 32) {
            const unsigned long long* slot = (const unsigned long long*)xbuf + (size_t)(u.pm * BM + row) * 4; float mt[4], m2[4]; float ms = 0.f;
#pragma unroll
            for (int t = 0; t < 4; ++t) { if (t < ntn) { const unsigned long long w = __hip_atomic_load(slot + t, __ATOMIC_RELAXED, __HIP_MEMORY_SCOPE_AGENT); mt[t] = __uint_as_float((unsigned)w); m2[t] = __uint_as_float((unsigned)(w >> 32)); } else { mt[t] = 0.f; m2[t] = 0.f; } ms += mt[t]; }
            const float mean = ms / (float)ntn; float q = 0.f;
#pragma unroll
            for (int t = 0; t < 4; ++t) if (t < ntn) { const float dm = mt[t] - mean; q += m2[t] + 256.0f * dm * dm; }
            S[row] = (f32x2v){mean, 1.0f / sqrtf(q / (256.0f * (float)ntn) + eps)};
        }
        asm volatile("s_waitcnt lgkmcnt(0)" ::: "memory"); __builtin_amdgcn_s_barrier(); asm volatile("" ::: "memory");
        return bad;
    }
};
struct EpiLnRes {
    static constexpr bool PERM = false, AFTER_DRAIN = true;
    const float* base; float* out; int ldc; const float* bias; PanelStats st; unsigned poison;
    __device__ __forceinline__ void fused(f32x4 (&acc)[2][2][4][2], const Unit& u, int wr, int wc, int fr, int fq, PG8_LAS unsigned char* lds, int wid, int lane) const {
        typedef float f32x2v __attribute__((ext_vector_type(2)));
        const PG8_LAS f32x2v* S = (const PG8_LAS f32x2v*)(lds + 8192);
        const int col0 = u.pn * BM + wc * 32 + 4 * fq;
#pragma unroll
        for (int bj = 0; bj < 2; ++bj)
#pragma unroll
            for (int n = 0; n < 2; ++n) { const f32x4 bv = bias ? *(const f32x4*)(bias + col0 + bj * HALF + n * 16) : (f32x4){0.f, 0.f, 0.f, 0.f};
#pragma unroll
                for (int ai = 0; ai < 2; ++ai)
#pragma unroll
                    for (int m = 0; m < 4; ++m) acc[ai][bj][m][n] += bv; }
        f32x4 pre[4][2][2];
#pragma unroll
        for (int m = 0; m < 4; ++m) { const size_t off = (size_t)(u.pm * BM + wr * 64 + m * 16 + fr) * ldc + col0;
#pragma unroll
            for (int bj = 0; bj < 2; ++bj)
#pragma unroll
                for (int n = 0; n < 2; ++n) pre[m][bj][n] = *(const f32x4*)(base + off + bj * HALF + n * 16); }
        const bool bad = st.run(acc, u, wr, wc, fr, fq, lds, wid, lane) || poison != 0u;
        const float qnan = __builtin_nanf("");
#pragma unroll
        for (int ai = 0; ai < 2; ++ai)
#pragma unroll
            for (int m = 0; m < 4; ++m) { const int r = ai * HALF + wr * 64 + m * 16 + fr; const f32x2v sr = S[r]; const size_t off = (size_t)(u.pm * BM + r) * ldc + col0;
#pragma unroll
                for (int bj = 0; bj < 2; ++bj)
#pragma unroll
                    for (int n = 0; n < 2; ++n) { const f32x4 bs = ai == 0 ? pre[m][bj][n] : *(const f32x4*)(base + off + bj * HALF + n * 16); f32x4 o = bs + (acc[ai][bj][m][n] - sr.x) * sr.y;
                        if (bad) o = (f32x4){qnan, qnan, qnan, qnan}; *(f32x4*)(out + off + bj * HALF + n * 16) = o; }
                if (m & 1) asm volatile("" ::: "memory"); }
    }
};
struct EpiLnResLn {
    static constexpr bool PERM = false, AFTER_DRAIN = true;
    const float* base; float* out; bf16_t* xn; int ldc; const float* bias; PanelStats st1, st2; unsigned poison;
    __device__ __forceinline__ void fused(f32x4 (&acc)[2][2][4][2], const Unit& u, int wr, int wc, int fr, int fq, PG8_LAS unsigned char* lds, int wid, int lane) const {
        typedef float f32x2v __attribute__((ext_vector_type(2))); typedef unsigned u32x2v __attribute__((ext_vector_type(2)));
        const PG8_LAS f32x2v* S = (const PG8_LAS f32x2v*)(lds + 8192);
        const int col0 = u.pn * BM + wc * 32 + 4 * fq;
#pragma unroll
        for (int bj = 0; bj < 2; ++bj)
#pragma unroll
            for (int n = 0; n < 2; ++n) { const f32x4 bv = bias ? *(const f32x4*)(bias + col0 + bj * HALF + n * 16) : (f32x4){0.f, 0.f, 0.f, 0.f};
#pragma unroll
                for (int ai = 0; ai < 2; ++ai)
#pragma unroll
                    for (int m = 0; m < 4; ++m) acc[ai][bj][m][n] += bv; }
        bool bad = st1.run(acc, u, wr, wc, fr, fq, lds, wid, lane) || poison != 0u;
        const float qnan = __builtin_nanf("");
#pragma unroll
        for (int ai = 0; ai < 2; ++ai)
#pragma unroll
            for (int m = 0; m < 4; ++m) { const int r = ai * HALF + wr * 64 + m * 16 + fr; const f32x2v sr = S[r]; const size_t off = (size_t)(u.pm * BM + r) * ldc + col0;
#pragma unroll
                for (int bj = 0; bj < 2; ++bj)
#pragma unroll
                    for (int n = 0; n < 2; ++n) { const f32x4 bs = *(const f32x4*)(base + off + bj * HALF + n * 16); acc[ai][bj][m][n] = bs + (acc[ai][bj][m][n] - sr.x) * sr.y; }
                asm volatile("" : "+v"(acc[ai][0][m][0]), "+v"(acc[ai][0][m][1]), "+v"(acc[ai][1][m][0]), "+v"(acc[ai][1][m][1]));
                if (m & 1) asm volatile("" ::: "memory"); }
        const bool bad1 = bad;
        bad = st2.run(acc, u, wr, wc, fr, fq, lds, wid, lane) || bad;
#pragma unroll
        for (int ai = 0; ai < 2; ++ai)
#pragma unroll
            for (int m = 0; m < 4; ++m) { const int r = ai * HALF + wr * 64 + m * 16 + fr; const f32x2v sr = S[r]; const size_t off = (size_t)(u.pm * BM + r) * ldc + col0;
#pragma unroll
                for (int bj = 0; bj < 2; ++bj)
#pragma unroll
                    for (int n = 0; n < 2; ++n) { const f32x4 x1 = acc[ai][bj][m][n]; *(f32x4*)(out + off + bj * HALF + n * 16) = bad1 ? (f32x4){qnan, qnan, qnan, qnan} : x1;
                        const f32x4 o = (x1 - sr.x) * sr.y; u32x2v w; w.x = cvt_pk_bf16(o[0], o[1]); w.y = cvt_pk_bf16(o[2], o[3]);
                        if (bad) { w.x = 0x7fc07fc0u; w.y = 0x7fc07fc0u; } *(u32x2v*)(xn + off + bj * HALF + n * 16) = w; }
                asm volatile("" ::: "memory"); }
    }
};

template <class Epi, class Sched, bool ALIGN_EPI = false, bool SP2 = false>
__device__ __forceinline__ void gemm_phase(PG8_LAS unsigned char* lds, const Gemm g, const Sched& S, const Epi& E) {
    int tid_ = threadIdx.x; asm volatile("" : "+v"(tid_));
    const int tid = tid_, wid = __builtin_amdgcn_readfirstlane(tid >> 6), lane = tid & 63, wr = wid >> 2, wc = wid & 3, fr = lane & 15, fq = lane >> 4;
    const int K = g.K, nt = K / BK;
    unsigned voffA[2], voffB[2];
#pragma unroll
    for (int i = 0; i < 2; ++i) { int R, C; stage_rc(tid * 16 + i * 8192, R, C); const int Rb = Epi::PERM ? ((R & ~31) + perm32(R & 31)) : R;
        voffA[i] = (unsigned)(R * K + C) * 2u; voffB[i] = (unsigned)(Rb * K + C) * 2u; }
    const size_t kstep = (size_t)(BK * 2);
    const size_t hstep = (size_t)HALF * K * 2;
    const size_t tstep = 2 * hstep;
    const unsigned ldsw = (unsigned)wid * 1024u;
    const int aoff = lds_byte(wr * 64 + fr, fq * 8), boff = lds_byte(wc * 32 + fr, fq * 8);
#define PG8_SA(b, h) (((b) * 2 + (h)) * HTB)
#define PG8_SB(b, h) ((4 + (b) * 2 + (h)) * HTB)
#define PG8_STAGE(bufoff, gbase, voff) do { _Pragma("unroll") for (int _i = 0; _i < 2; ++_i) \
        __builtin_amdgcn_global_load_lds((const unsigned*)((const char*)(gbase) + (voff)[_i]), (PG8_LAS unsigned*)(lds + (bufoff) + ldsw + _i * 8192), 16, 0, 0); } while (0)
#define PG8_LDA(dst, b, h) do { _Pragma("unroll") for (int m = 0; m < 4; ++m) _Pragma("unroll") for (int k = 0; k < 2; ++k) dst[m][k] = *(const PG8_LAS bf16x8*)(lds + PG8_SA(b, h) + aoff + m * 2048 + k * 1024); } while (0)
#define PG8_LDB(dst, b, h) do { _Pragma("unroll") for (int n = 0; n < 2; ++n) _Pragma("unroll") for (int k = 0; k < 2; ++k) dst[n][k] = *(const PG8_LAS bf16x8*)(lds + PG8_SB(b, h) + boff + n * 2048 + k * 1024); } while (0)
#define PG8_MMA(ai, bj, At, Bt) do { __builtin_amdgcn_s_setprio(1); _Pragma("unroll") for (int m = 0; m < 4; ++m) _Pragma("unroll") for (int n = 0; n < 2; ++n) _Pragma("unroll") for (int k = 0; k < 2; ++k) \
        acc[ai][bj][m][n] = __builtin_amdgcn_mfma_f32_16x16x32_bf16(Bt[n][k], At[m][k], acc[ai][bj][m][n], 0, 0, 0); __builtin_amdgcn_s_setprio(0); } while (0)
#define PG8_WAIT_V(n) asm volatile("s_waitcnt vmcnt(" #n ")" ::: "memory")
#define PG8_WAIT_L(n) asm volatile("s_waitcnt lgkmcnt(" #n ")" ::: "memory")
#define PG8_BAR __builtin_amdgcn_s_barrier()
#define PG8_SCHED __builtin_amdgcn_sched_barrier(0)
    Unit cur, nxt; int ui = 0;
    if (!S.next(0, cur)) return;
    f32x4 acc[2][2][4][2];
#pragma unroll
    for (int a = 0; a < 2; ++a)
#pragma unroll
        for (int b = 0; b < 2; ++b)
#pragma unroll
            for (int m = 0; m < 4; ++m)
#pragma unroll
                for (int n = 0; n < 2; ++n) acc[a][b][m][n] = (f32x4){0.f, 0.f, 0.f, 0.f};
    bf16x8 At[4][2], B0[2][2], B1[2][2];
    const char* cA = (const char*)g.A + (size_t)cur.pm * tstep; const char* cB = (const char*)g.Bt + (size_t)cur.pn * tstep;
    S.a_ready(cur);
    if constexpr (SP2) {
        PG8_STAGE(PG8_SB(0, 0), cB, voffB); PG8_STAGE(PG8_SB(0, 1), cB + hstep, voffB); PG8_STAGE(PG8_SA(0, 0), cA, voffA); PG8_STAGE(PG8_SA(0, 1), cA + hstep, voffA);
        if (wr == 1) PG8_BAR;
        PG8_WAIT_V(2); PG8_BAR;
        PG8_STAGE(PG8_SB(1, 0), cB + kstep, voffB); PG8_STAGE(PG8_SA(1, 0), cA + kstep, voffA); PG8_STAGE(PG8_SB(1, 1), cB + hstep + kstep, voffB);
        PG8_WAIT_V(6); PG8_BAR;
    } else {
        PG8_STAGE(PG8_SB(0, 0), cB, voffB); PG8_STAGE(PG8_SA(0, 0), cA, voffA); PG8_STAGE(PG8_SB(0, 1), cB + hstep, voffB); PG8_STAGE(PG8_SA(0, 1), cA + hstep, voffA);
        if (wr == 1) PG8_BAR;
        PG8_WAIT_V(4); PG8_BAR;
        PG8_STAGE(PG8_SB(1, 0), cB + kstep, voffB); PG8_STAGE(PG8_SA(1, 0), cA + kstep, voffA); PG8_STAGE(PG8_SB(1, 1), cB + hstep + kstep, voffB);
        PG8_WAIT_V(6); PG8_BAR;
    }
    for (;;) {
        const bool has_next = S.next(ui + 1, nxt);
        const char* nA = has_next ? (const char*)g.A + (size_t)nxt.pm * tstep : cA; const char* nB = has_next ? (const char*)g.Bt + (size_t)nxt.pn * tstep : cB;
        for (int t = 0; t < nt; t += 2) {
            const bool last = (t == nt - 2);
            const char* a1 = cA + (size_t)(t + 1) * kstep;
            const char* a2 = last ? nA : cA + (size_t)(t + 2) * kstep; const char* b2 = last ? nB : cB + (size_t)(t + 2) * kstep;
            const char* a3 = a2 + kstep; const char* b3 = b2 + kstep;
            if (last && has_next) S.a_ready(nxt);
            if constexpr (SP2) {
            PG8_LDB(B0, 0, 0); PG8_LDB(B1, 0, 1); PG8_SCHED; PG8_LDA(At, 0, 0); PG8_STAGE(PG8_SA(1, 1), a1 + hstep, voffA);
            PG8_WAIT_V(8); PG8_WAIT_L(0); PG8_BAR; PG8_MMA(0, 0, At, B0); PG8_MMA(0, 1, At, B1); PG8_BAR; PG8_SCHED;
            PG8_LDA(At, 0, 1); PG8_STAGE(PG8_SB(0, 0), b2, voffB); PG8_STAGE(PG8_SB(0, 1), b2 + hstep, voffB); PG8_STAGE(PG8_SA(0, 0), a2, voffA);
            PG8_WAIT_V(8); PG8_WAIT_L(0); PG8_BAR; PG8_MMA(1, 0, At, B0); PG8_MMA(1, 1, At, B1); PG8_BAR; PG8_SCHED;
            PG8_LDB(B0, 1, 0); PG8_LDB(B1, 1, 1); PG8_SCHED; PG8_LDA(At, 1, 0); PG8_STAGE(PG8_SA(0, 1), a2 + hstep, voffA);
            PG8_WAIT_V(8); PG8_WAIT_L(0); PG8_BAR; PG8_MMA(0, 0, At, B0); PG8_MMA(0, 1, At, B1); PG8_BAR; PG8_SCHED;
            PG8_LDA(At, 1, 1); PG8_STAGE(PG8_SB(1, 0), b3, voffB); PG8_STAGE(PG8_SB(1, 1), b3 + hstep, voffB); PG8_STAGE(PG8_SA(1, 0), a3, voffA);
            PG8_WAIT_V(8); PG8_WAIT_L(0); PG8_BAR; PG8_MMA(1, 0, At, B0); PG8_MMA(1, 1, At, B1); PG8_BAR; PG8_SCHED;
            } else {
            PG8_LDB(B0, 0, 0); PG8_SCHED; PG8_LDA(At, 0, 0); PG8_STAGE(PG8_SA(1, 1), a1 + hstep, voffA);
            PG8_WAIT_L(8); PG8_BAR; PG8_WAIT_L(0); PG8_MMA(0, 0, At, B0); PG8_BAR; PG8_SCHED;
            PG8_LDB(B1, 0, 1); PG8_STAGE(PG8_SB(0, 0), b2, voffB);
            PG8_BAR; PG8_WAIT_L(0); PG8_MMA(0, 1, At, B1); PG8_BAR;
            PG8_LDA(At, 0, 1); PG8_STAGE(PG8_SA(0, 0), a2, voffA);
            PG8_BAR; PG8_WAIT_L(0); PG8_MMA(1, 0, At, B0); PG8_BAR; PG8_SCHED;
            PG8_STAGE(PG8_SB(0, 1), b2 + hstep, voffB);
            PG8_WAIT_V(6); PG8_BAR; PG8_MMA(1, 1, At, B1); PG8_BAR;
            PG8_LDB(B0, 1, 0); PG8_SCHED; PG8_LDA(At, 1, 0); PG8_STAGE(PG8_SA(0, 1), a2 + hstep, voffA);
            PG8_WAIT_L(8); PG8_BAR; PG8_WAIT_L(0); PG8_MMA(0, 0, At, B0); PG8_BAR; PG8_SCHED;
            PG8_LDB(B1, 1, 1); PG8_STAGE(PG8_SB(1, 0), b3, voffB);
            PG8_BAR; PG8_WAIT_L(0); PG8_MMA(0, 1, At, B1); PG8_BAR;
            PG8_LDA(At, 1, 1); PG8_STAGE(PG8_SA(1, 0), a3, voffA);
            PG8_BAR; PG8_WAIT_L(0); PG8_MMA(1, 0, At, B0); PG8_BAR; PG8_SCHED;
            PG8_STAGE(PG8_SB(1, 1), b3 + hstep, voffB);
            PG8_WAIT_V(6); PG8_BAR; PG8_MMA(1, 1, At, B1); PG8_BAR;
            }
        }
        if constexpr (ALIGN_EPI) { if (wr == 0) PG8_BAR; }
        if constexpr (!Epi::AFTER_DRAIN) { E(acc, cur, wr, wc, fr, fq); S.done(cur); }
        if (!has_next) break;
#pragma unroll
        for (int a = 0; a < 2; ++a)
#pragma unroll
            for (int b = 0; b < 2; ++b)
#pragma unroll
                for (int m = 0; m < 4; ++m)
#pragma unroll
                    for (int n = 0; n < 2; ++n) acc[a][b][m][n] = (f32x4){0.f, 0.f, 0.f, 0.f};
        cur = nxt; cA = nA; cB = nB; ++ui;
        if constexpr (ALIGN_EPI) { if (wr == 1) PG8_BAR; }
    }
    PG8_WAIT_V(0);
    if constexpr (!ALIGN_EPI) { if (wr == 0) PG8_BAR; }
    PG8_BAR;
    if constexpr (Epi::AFTER_DRAIN) { E.fused(acc, cur, wr, wc, fr, fq, lds, wid, lane); S.done(cur); }
#undef PG8_SA
#undef PG8_SB
#undef PG8_STAGE
#undef PG8_LDA
#undef PG8_LDB
#undef PG8_MMA
#undef PG8_WAIT_V
#undef PG8_WAIT_L
#undef PG8_BAR
#undef PG8_SCHED
}
}

#include <hip/hip_cooperative_groups.h>
namespace cg = cooperative_groups;

#define GAS __attribute__((address_space(1)))
#define LAS __attribute__((address_space(3)))
typedef unsigned short bf16;
typedef unsigned v4u __attribute__((ext_vector_type(4)));
typedef unsigned v2u __attribute__((ext_vector_type(2)));
typedef float f32x4 __attribute__((ext_vector_type(4)));
typedef short bf16x8 __attribute__((ext_vector_type(8)));
#define LDS_WAIT() asm volatile("s_waitcnt lgkmcnt(0)" ::: "memory")

constexpr int BATCH = 2, SEQ = 16384, D = 1024, M = BATCH * SEQ, NIN = 3584, FF = 4096, DEPTH = 2;
constexpr int HW = 512;
constexpr float ALPHA = 1.4142135623730951f;
constexpr float LN_EPS = 1e-5f, RMS_EPS = 1e-6f;
constexpr size_t MiB = 1u << 20;
constexpr size_t WS_W = 0;
constexpr size_t W_LAYER = 25 * MiB, W_IN = 0, W_O = 7 * MiB, W_1 = 9 * MiB, W_2 = 17 * MiB;
constexpr size_t WS_XB = 52 * MiB;
constexpr size_t WS_A = 116 * MiB;
constexpr size_t SEG_BYTES = 32 * MiB;
constexpr size_t WS_LF = WS_A + 6 * SEG_BYTES;
constexpr size_t WS_B = 372 * MiB;
constexpr size_t WS_ORAW = WS_B + 64 * MiB;
constexpr size_t WS_END = 500 * MiB;
constexpr int LDS_BYTES = 131072 + 2048;
constexpr int NWAVES = 8;

__device__ __forceinline__ unsigned f2bf(float f) { unsigned u = __builtin_bit_cast(unsigned, f); return (u + 0x7fffu + ((u >> 16) & 1u)) >> 16; }
__device__ __forceinline__ unsigned pk2(float lo, float hi) { return f2bf(lo) | (f2bf(hi) << 16); }
__device__ __forceinline__ float bf2f(unsigned short h) { return __builtin_bit_cast(float, (unsigned)h << 16); }
__device__ __forceinline__ float bflo(unsigned w) { return __builtin_bit_cast(float, w << 16); }
__device__ __forceinline__ float bfhi(unsigned w) { return __builtin_bit_cast(float, w & 0xffff0000u); }
__device__ __forceinline__ float wave_sum(float v) {
#pragma unroll
    for (int o = 1; o < 64; o <<= 1) v += __shfl_xor(v, o);
    return v;
}
__device__ __forceinline__ float wave_max(float v) {
#pragma unroll
    for (int o = 1; o < 64; o <<= 1) v = fmaxf(v, __shfl_xor(v, o));
    return v;
}

namespace pg8 {
struct EpiInProj {
    static constexpr bool PERM = true, AFTER_DRAIN = false;
    bf16_t* seg; float* lf; const float* lb0; const float* lb1; int layer;
    __device__ __forceinline__ void operator()(const f32x4 (&acc)[2][2][4][2], const Unit& u, int wr, int wc, int fr, int fq) const {
        const int t = u.pn >> 1;
        int row0 = u.pm * BM + wr * 64 + fr;
        int cs0 = (u.pn & 1) * 256 + wc * 32 + 8 * fq; asm volatile("" : "+v"(row0), "+v"(cs0));
        if (t == 1) {
#pragma unroll
            for (int bj = 0; bj < 2; ++bj) {
                float lbv[8];
#pragma unroll
                for (int i = 0; i < 8; ++i) { const int c = cs0 + bj * HALF + i; lbv[i] = layer ? 1.0f / (1.0f + __expf(-(lb1[c] - lb0[c]))) : 0.0f; }
#pragma unroll
                for (int ai = 0; ai < 2; ++ai)
#pragma unroll
                    for (int m = 0; m < 4; ++m) {
                        float* p = lf + (size_t)(row0 + ai * HALF + m * 16) * 512 + cs0 + bj * HALF;
                        f32x4 o[2];
#pragma unroll
                        for (int n = 0; n < 2; ++n)
#pragma unroll
                            for (int e = 0; e < 4; ++e) { const float z = acc[ai][bj][m][n][e]; const float sg = 1.0f / (1.0f + __expf(-z)); const float lb = lbv[n * 4 + e]; o[n][e] = __logf(lb + (1.0f - lb) * sg); }
                        *(f32x4*)p = o[0]; *(f32x4*)(p + 4) = o[1]; asm volatile("" ::: "memory");
                    }
            }
        } else {
            const int di = t == 0 ? 0 : t - 1;
            bf16_t* base = seg + (size_t)di * ((size_t)32 * 1024 * 1024 / 2);
#pragma unroll
            for (int ai = 0; ai < 2; ++ai)
#pragma unroll
                for (int m = 0; m < 4; ++m)
#pragma unroll
                    for (int bj = 0; bj < 2; ++bj) {
                        float v[8];
#pragma unroll
                        for (int n = 0; n < 2; ++n)
#pragma unroll
                            for (int e = 0; e < 4; ++e) { float z = acc[ai][bj][m][n][e];
                                if (t == 0) z = z / (1.0f + __expf(-z));
                                else if (t == 3) z = 1.0f / (1.0f + __expf(-z));
                                else if (t == 4) z = z * 0.125f;
                                v[n * 4 + e] = z; }
                        u32x4 w; w.x = cvt_pk_bf16(v[0], v[1]); w.y = cvt_pk_bf16(v[2], v[3]); w.z = cvt_pk_bf16(v[4], v[5]); w.w = cvt_pk_bf16(v[6], v[7]);
                        *(u32x4*)(base + (size_t)(row0 + ai * HALF + m * 16) * 512 + cs0 + bj * HALF) = w;
                    }
        }
    }
};
struct EpiResid {
    static constexpr bool PERM = true, AFTER_DRAIN = false;
    const float* res; float* out; float alpha;
    __device__ __forceinline__ void operator()(const f32x4 (&acc)[2][2][4][2], const Unit& u, int wr, int wc, int fr, int fq) const {
        int row0 = u.pm * BM + wr * 64 + fr; int col0 = u.pn * BM + wc * 32 + 8 * fq; asm volatile("" : "+v"(row0), "+v"(col0));
#pragma unroll
        for (int ai = 0; ai < 2; ++ai)
#pragma unroll
            for (int m = 0; m < 4; ++m)
#pragma unroll
                for (int bj = 0; bj < 2; ++bj) {
                    const size_t off = (size_t)(row0 + ai * HALF + m * 16) * 1024 + col0 + bj * HALF;
                    const f32x4 r0 = *(const f32x4*)(res + off), r1 = *(const f32x4*)(res + off + 4);
                    *(f32x4*)(out + off) = r0 * alpha + acc[ai][bj][m][0]; *(f32x4*)(out + off + 4) = r1 * alpha + acc[ai][bj][m][1];
                    if (bj == 1) asm volatile("" ::: "memory");
                }
    }
};
struct EpiSqRelu {
    static constexpr bool PERM = true, AFTER_DRAIN = false;
    bf16_t* out;
    __device__ __forceinline__ void operator()(const f32x4 (&acc)[2][2][4][2], const Unit& u, int wr, int wc, int fr, int fq) const {
        int row0 = u.pm * BM + wr * 64 + fr; int col0 = u.pn * BM + wc * 32 + 8 * fq; asm volatile("" : "+v"(row0), "+v"(col0));
#pragma unroll
        for (int ai = 0; ai < 2; ++ai)
#pragma unroll
            for (int m = 0; m < 4; ++m)
#pragma unroll
                for (int bj = 0; bj < 2; ++bj) {
                    f32x4 a = acc[ai][bj][m][0], b = acc[ai][bj][m][1];
#pragma unroll
                    for (int e = 0; e < 4; ++e) { a[e] = fmaxf(a[e], 0.f); a[e] *= a[e]; b[e] = fmaxf(b[e], 0.f); b[e] *= b[e]; }
                    u32x4 w; w.x = cvt_pk_bf16(a[0], a[1]); w.y = cvt_pk_bf16(a[2], a[3]); w.z = cvt_pk_bf16(b[0], b[1]); w.w = cvt_pk_bf16(b[2], b[3]);
                    *(u32x4*)(out + (size_t)(row0 + ai * HALF + m * 16) * 4096 + col0 + bj * HALF) = w;
                }
    }
};
}

__device__ __forceinline__ void p0_transpose_item(const float* W, int K, int N, bf16* WT, LAS float* scr, int item, int lane) {
    asm volatile("" : "+v"(lane));
    const int nblk = N / 32, kb = item / nblk, nb = item % nblk, k0 = 64 * kb, n0 = 32 * nb;
#pragma unroll 8
    for (int i = 0; i < 32; ++i) { const int kk = 2 * i + (lane >> 5); scr[kk * 33 + (lane & 31)] = W[(size_t)(k0 + kk) * N + n0 + (lane & 31)]; }
    LDS_WAIT(); asm volatile("" ::: "memory");
    const int c = lane & 7;
#pragma unroll
    for (int j = 0; j < 4; ++j) { const int n = (lane >> 3) + 8 * j; const LAS float* s = scr + (8 * c) * 33 + n;
        v4u o; o.x = pk2(s[0 * 33], s[1 * 33]); o.y = pk2(s[2 * 33], s[3 * 33]); o.z = pk2(s[4 * 33], s[5 * 33]); o.w = pk2(s[6 * 33], s[7 * 33]);
        *(GAS v4u*)(WT + (size_t)(n0 + n) * K + k0 + 8 * c) = o; }
    LDS_WAIT(); asm volatile("" ::: "memory");
}

struct Args { const float* in[11]; float* out; unsigned char* ws; };

__device__ __forceinline__ void ln_rows(const float* src, float* dst, bf16* xb, const float* g, const float* b, int gw, int NGW, int lane) {
    asm volatile("" : "+v"(lane));
    f32x4 gv[4], bv[4];
#pragma unroll
    for (int j = 0; j < 4; ++j) { gv[j] = *((const f32x4*)g + lane + 64 * j); bv[j] = *((const f32x4*)b + lane + 64 * j); }
    for (int m = gw; m < M; m += NGW) {
        const f32x4* xr = (const f32x4*)(src + (size_t)m * D) + lane;
        f32x4 v[4]; float s = 0.f;
#pragma unroll
        for (int j = 0; j < 4; ++j) { v[j] = xr[64 * j]; s += (v[j].x + v[j].y) + (v[j].z + v[j].w); }
        const float mean = wave_sum(s) * (1.f / D); float s2 = 0.f;
#pragma unroll
        for (int j = 0; j < 4; ++j) { v[j] = v[j] - mean; s2 += (v[j].x * v[j].x + v[j].y * v[j].y) + (v[j].z * v[j].z + v[j].w * v[j].w); }
        const float rstd = 1.f / sqrtf(wave_sum(s2) * (1.f / D) + LN_EPS);
        f32x4* o4 = (f32x4*)(dst + (size_t)m * D) + lane;
        v2u* o8 = (v2u*)(xb + (size_t)m * D) + lane;
#pragma unroll
        for (int j = 0; j < 4; ++j) { const f32x4 y = v[j] * rstd * gv[j] + bv[j]; o4[64 * j] = y; v2u w; w.x = pk2(y.x, y.y); w.y = pk2(y.z, y.w); o8[64 * j] = w; }
    }
}

__device__ __forceinline__ void hgrn_simple(const bf16* QS, const float* LF, const bf16* VI, float* ORAW, int gw, int lane) {
    asm volatile("" : "+v"(lane));
    if (gw >= BATCH * 4 * 128) return;
    const int b = gw >> 9, h = (gw >> 7) & 3, v = gw & 127;
    float S0 = 0.f, S1 = 0.f;
    const size_t rb = (size_t)b * SEQ;
    for (int t0 = 0; t0 < SEQ; t0 += 16) {
        float lf0[16], lf1[16], q0[16], q1[16], vv[16];
#pragma unroll
        for (int i = 0; i < 16; ++i) { const size_t o = (rb + t0 + i) * 512 + h * 128;
            lf0[i] = LF[o + lane]; lf1[i] = LF[o + 64 + lane]; q0[i] = bf2f(QS[o + lane]); q1[i] = bf2f(QS[o + 64 + lane]); vv[i] = bf2f(VI[o + v]); }
        float res = 0.f;
#pragma unroll
        for (int i = 0; i < 16; ++i) {
            const float f0 = __expf(lf0[i]), f1 = __expf(lf1[i]);
            S0 = f0 * S0 + (1.f - f0) * vv[i]; S1 = f1 * S1 + (1.f - f1) * vv[i];
            const float p = wave_sum(q0[i] * S0 + q1[i] * S1);
            if (lane == i) res = p;
        }
        if (lane < 16) ORAW[(rb + t0 + lane) * 512 + h * 128 + v] = res;
    }
}
__device__ __forceinline__ void hgrn_finalize(const float* ORAW, const bf16* GT, const float* nw, bf16* O, int gw, int NGW, int lane) {
    asm volatile("" : "+v"(lane));
    for (int it = gw; it < M * 4; it += NGW) {
        const int row = it >> 2, h = it & 3; const size_t o = (size_t)row * 512 + h * 128 + 2 * lane;
        const float a = ORAW[o], c = ORAW[o + 1];
        const float ss = wave_sum(a * a + c * c);
        const float r = 1.0f / sqrtf(ss * (1.f / 128.f) + RMS_EPS);
        const unsigned gt = *(const unsigned*)(GT + o);
        const float y0 = a * r * nw[h * 128 + 2 * lane] * bflo(gt), y1 = c * r * nw[h * 128 + 2 * lane + 1] * bfhi(gt);
        *(unsigned*)(O + (size_t)row * D + h * 128 + 2 * lane) = pk2(y0, y1);
    }
}
__device__ __forceinline__ float dot8(v4u a, v4u b) {
    return bflo(a.x) * bflo(b.x) + bfhi(a.x) * bfhi(b.x) + bflo(a.y) * bflo(b.y) + bfhi(a.y) * bfhi(b.y) + bflo(a.z) * bflo(b.z) + bfhi(a.z) * bfhi(b.z) + bflo(a.w) * bflo(b.w) + bfhi(a.w) * bfhi(b.w);
}
__device__ __forceinline__ void attn_simple(const bf16* AQ, const bf16* AK, const bf16* AV, bf16* O, LAS float* pbuf, int gw, int NGW, int lane) {
    asm volatile("" : "+v"(lane));
    for (int it = gw; it < M * 8; it += NGW) {
        const int row = it >> 3, h = it & 7, b = row / SEQ, t = row % SEQ;
        const v4u* qp = (const v4u*)(AQ + (size_t)row * 512 + h * 64);
        v4u q[8];
#pragma unroll
        for (int i = 0; i < 8; ++i) q[i] = qp[i];
        float sc[6]; float mx = -INFINITY;
#pragma unroll
        for (int p = 0; p < 3; ++p) { const int d = p == 0 ? 1 : (p == 1 ? 4 : 16);
#pragma unroll
            for (int c = 0; c < 2; ++c) { const int j = 1 + 64 * c + lane; const int s = t - j * d; float a = -INFINITY;
                if (s >= 0) { const v4u* kp = (const v4u*)(AK + ((size_t)b * SEQ + s) * 512 + h * 64); a = 0.f;
#pragma unroll
                    for (int i = 0; i < 8; ++i) a += dot8(q[i], kp[i]); }
                sc[p * 2 + c] = a; mx = fmaxf(mx, a); } }
        float sself = 0.f; { const v4u* kp = (const v4u*)(AK + (size_t)row * 512 + h * 64);
#pragma unroll
            for (int i = 0; i < 8; ++i) sself += dot8(q[i], kp[i]); }
        mx = fmaxf(wave_max(mx), sself);
        float l = 0.f;
#pragma unroll
        for (int i = 0; i < 6; ++i) { const float e = __expf(sc[i] - mx); pbuf[i * 64 + lane] = e; l += e; }
        const float pself = 3.0f * __expf(sself - mx);
        l = wave_sum(l) + pself;
        LDS_WAIT(); asm volatile("" ::: "memory");
        float o = pself * bf2f(AV[(size_t)row * 512 + h * 64 + lane]);
#pragma unroll
        for (int p = 0; p < 3; ++p) { const int d = p == 0 ? 1 : (p == 1 ? 4 : 16);
            int jmax = t / d; if (jmax > 128) jmax = 128;
#pragma unroll 8
            for (int j = 1; j <= jmax; ++j) o += pbuf[p * 128 + j - 1] * bf2f(AV[((size_t)b * SEQ + t - j * d) * 512 + h * 64 + lane]);
        }
        O[(size_t)row * D + 512 + h * 64 + lane] = (bf16)f2bf(o / l);
        LDS_WAIT(); asm volatile("" ::: "memory");
    }
}

__global__ void __launch_bounds__(512, 2) fwd_mega(Args args) {
    extern __shared__ __attribute__((aligned(16))) unsigned char lds[];
    cg::grid_group grid = cg::this_grid();
    LAS unsigned char* L = (LAS unsigned char*)lds;
    const int tid = threadIdx.x, lane = tid & 63, wave = __builtin_amdgcn_readfirstlane(tid >> 6);
    const int G = gridDim.x, gw = blockIdx.x * NWAVES + wave, NGW = G * NWAVES;
    unsigned char* ws = args.ws;
    const float* x_in = args.in[0];
    bf16* XB = (bf16*)(ws + WS_XB);
    bf16* SEGB = (bf16*)(ws + WS_A);
    bf16* QS = SEGB; bf16* VI = SEGB + 1 * (SEG_BYTES / 2); bf16* GT = SEGB + 2 * (SEG_BYTES / 2);
    bf16* AQ = SEGB + 3 * (SEG_BYTES / 2); bf16* AK = SEGB + 4 * (SEG_BYTES / 2); bf16* AV = SEGB + 5 * (SEG_BYTES / 2);
    float* LF = (float*)(ws + WS_LF);
    float* Y = (float*)(ws + WS_A);
    bf16* H = (bf16*)(ws + WS_A);
    bf16* O = (bf16*)(ws + WS_B);
    float* ORAW = (float*)(ws + WS_ORAW);
    float* Y2 = (float*)(ws + WS_B);
    float* out = args.out;

    {
        LAS float* scr = (LAS float*)(L + wave * 16384);
        for (int l = 0; l < DEPTH; ++l) {
            bf16* wl = (bf16*)(ws + WS_W + l * W_LAYER);
            constexpr int I_IN = (D / 64) * (NIN / 32), I_O = (D / 64) * (D / 32), I_1 = (D / 64) * (FF / 32), I_2 = (FF / 64) * (D / 32);
            for (int it = gw; it < I_IN + I_O + I_1 + I_2; it += NGW) {
                int r = it;
                if (r < I_IN) { p0_transpose_item(args.in[1] + (size_t)l * D * NIN, D, NIN, wl + W_IN / 2, scr, r, lane); continue; } r -= I_IN;
                if (r < I_O) { p0_transpose_item(args.in[2] + (size_t)l * D * D, D, D, wl + W_O / 2, scr, r, lane); continue; } r -= I_O;
                if (r < I_1) { p0_transpose_item(args.in[7] + (size_t)l * D * FF, D, FF, wl + W_1 / 2, scr, r, lane); continue; } r -= I_1;
                p0_transpose_item(args.in[8] + (size_t)l * FF * D, FF, D, wl + W_2 / 2, scr, r, lane);
            }
        }
        for (size_t i = (size_t)blockIdx.x * 512 + tid; i < (size_t)M * D / 4; i += (size_t)G * 512) {
            const f32x4 v = ((const f32x4*)x_in)[i]; v2u w; w.x = pk2(v.x, v.y); w.y = pk2(v.z, v.w); ((v2u*)XB)[i] = w; }
    }
    grid.sync();

    for (int l = 0; l < DEPTH; ++l) {
        const bf16* wl = (const bf16*)(ws + WS_W + l * W_LAYER);
        const float* res0 = l == 0 ? x_in : out;
        {
            pg8::Gemm g{XB, wl + W_IN / 2, M, NIN, D}; pg8::StaticOrder S; { int bx = blockIdx.x, Gs = G; asm volatile("" : "+s"(bx), "+s"(Gs)); S.init(M, NIN, Gs, bx); }
            pg8::EpiInProj E{SEGB, LF, args.in[3], args.in[3] + HW, l};
            pg8::gemm_phase<pg8::EpiInProj, pg8::StaticOrder, true, true>(L, g, S, E);
        }
        grid.sync();
        hgrn_simple(QS, LF, VI, ORAW, gw, lane);
        attn_simple(AQ, AK, AV, O, (LAS float*)(L + wave * 2048), gw, NGW, lane);
        grid.sync();
        hgrn_finalize(ORAW, GT, args.in[4] + l * HW, O, gw, NGW, lane);
        grid.sync();
        {
            pg8::Gemm g{O, wl + W_O / 2, M, D, D}; pg8::StaticOrder S; { int bx = blockIdx.x, Gs = G; asm volatile("" : "+s"(bx), "+s"(Gs)); S.init(M, D, Gs, bx); }
            pg8::EpiResid E{res0, Y, ALPHA};
            pg8::gemm_phase<pg8::EpiResid, pg8::StaticOrder, true, true>(L, g, S, E);
        }
        grid.sync();
        ln_rows(Y, out, XB, args.in[5] + l * D, args.in[6] + l * D, gw, NGW, lane);
        grid.sync();
        {
            pg8::Gemm g{XB, wl + W_1 / 2, M, FF, D}; pg8::StaticOrder S; { int bx = blockIdx.x, Gs = G; asm volatile("" : "+s"(bx), "+s"(Gs)); S.init(M, FF, Gs, bx); }
            pg8::EpiSqRelu E{H};
            pg8::gemm_phase<pg8::EpiSqRelu, pg8::StaticOrder, true, true>(L, g, S, E);
        }
        grid.sync();
        {
            pg8::Gemm g{H, wl + W_2 / 2, M, D, FF}; pg8::StaticOrder S; { int bx = blockIdx.x, Gs = G; asm volatile("" : "+s"(bx), "+s"(Gs)); S.init(M, D, Gs, bx); }
            pg8::EpiResid E{out, Y2, ALPHA};
            pg8::gemm_phase<pg8::EpiResid, pg8::StaticOrder, true, true>(L, g, S, E);
        }
        grid.sync();
        ln_rows(Y2, out, XB, args.in[9] + l * D, args.in[10] + l * D, gw, NGW, lane);
        if (l + 1 < DEPTH) grid.sync();
    }
}

extern "C" void kernel_launch(void* const* d_in, const int* in_sizes, int n_in, void* d_out, int out_size, void* d_ws, size_t ws_size, hipStream_t stream) {
    static int grid = 0;
    if (grid == 0) {
        if (n_in != 11 || in_sizes[0] != M * D || out_size != M * D || ws_size < WS_END) { fprintf(stderr, "kernel_launch: unexpected shapes / workspace (%d inputs, ws %zu)\n", n_in, ws_size); grid = -1; return; }
        int dev = 0, cus = 0, per_cu = 0;
        hipGetDevice(&dev); hipDeviceGetAttribute(&cus, hipDeviceAttributeMultiprocessorCount, dev);
        hipFuncSetAttribute((const void*)fwd_mega, hipFuncAttributeMaxDynamicSharedMemorySize, LDS_BYTES);
        hipOccupancyMaxActiveBlocksPerMultiprocessor(&per_cu, (const void*)fwd_mega, 512, LDS_BYTES);
        if (per_cu < 1) per_cu = 1;
        grid = cus;
        (void)hipGetLastError();
    }
    if (grid < 0) return;
    Args a{};
    for (int i = 0; i < 11; ++i) a.in[i] = (const float*)d_in[i];
    a.out = (float*)d_out; a.ws = (unsigned char*)d_ws;
    void* kargs[] = {&a};
    hipError_t e = hipLaunchCooperativeKernel((const void*)fwd_mega, dim3(grid), dim3(512), kargs, LDS_BYTES, stream);
    if (e != hipSuccess) fprintf(stderr, "cooperative launch failed: %s (grid %d)\n", hipGetErrorString(e), grid);
}
```

```cpp
#include <hip/hip_runtime.h>
#include <cstdio>
#include <cstdint>
namespace pg8 {
#define PG8_LAS __attribute__((address_space(3)))
typedef unsigned short bf16_t;
typedef short bf16x8 __attribute__((ext_vector_type(8)));
typedef float f32x4 __attribute__((ext_vector_type(4)));
typedef unsigned u32x4 __attribute__((ext_vector_type(4)));
constexpr int BM = 256, BK = 64, HALF = 128, HTB = HALF * BK * 2  , STAGE_BYTES = 8 * HTB, NXCD = 8, WGM = 8;

__host__ __device__ __forceinline__ int lds_byte(int r, int c) { const int st = (r >> 4) * 2 + (c >> 5), rr = r & 15, cc = c & 31, ob = rr * 64 + cc * 2; return st * 1024 + (ob ^ (((ob >> 9) & 1) << 5)); }
__host__ __device__ __forceinline__ void stage_rc(int b, int& R, int& C) { const int st = b / 1024, sb = b % 1024, swz = sb ^ (((sb >> 9) & 1) << 5); R = (st >> 1) * 16 + swz / 64; C = (st & 1) * 32 + (swz % 64) / 2; }
__host__ __device__ __forceinline__ int perm32(int rho) { const int n = rho >> 4, i = rho & 15; return 8 * (i >> 2) + 4 * n + (i & 3); }

struct Unit { int pm, pn; };
struct Gemm { const bf16_t* A; const bf16_t* Bt; int M, N, K; };

struct StaticOrder {
    int nM, nN, nwg, G, c;
    __host__ __device__ void init(int M, int N, int G_, int c_) { nM = M / BM; nN = N / BM; nwg = nM * nN; G = G_; c = c_; }
    __host__ __device__ bool next(int i, Unit& u) const {
        const long L = (long)i * G + c; if (L >= nwg) return false;
        int wgid = (int)L; { const int q = nwg / NXCD, r = nwg % NXCD, xcd = wgid % NXCD, off = wgid / NXCD; wgid = (xcd < r ? xcd * (q + 1) : r * (q + 1) + (xcd - r) * q) + off; }
        const int nig = WGM * nN, gid = wgid / nig, fm = gid * WGM, gsz = (nM - fm) < WGM ? (nM - fm) : WGM;
        u.pm = fm + ((wgid % nig) % gsz); u.pn = (wgid % nig) / gsz; return true;
    }
    __device__ __forceinline__ void a_ready(const Unit&) const {}
    __device__ __forceinline__ void done(const Unit&) const {}
};

__device__ __forceinline__ unsigned cvt_pk_bf16(float lo, float hi) { unsigned r; asm volatile("v_cvt_pk_bf16_f32 %0, %1, %2" : "=v"(r) : "v"(lo), "v"(hi)); return r; }
typedef float f32x2 __attribute__((ext_vector_type(2)));
__device__ __forceinline__ f32x2 gelu_pk(f32x2 v) {
    const f32x2 av = __builtin_elementwise_abs(v), d = av * 0.2316418882f + 1.0f;
    f32x2 t; t.x = __builtin_amdgcn_rcpf(d.x); t.y = __builtin_amdgcn_rcpf(d.y);
    f32x2 q = t * 0.5307027145f + (-0.7265760135f); q = q * t + 0.7107068705f; q = q * t + (-0.142248368f); q = q * t + 0.127414796f; q = q * t;
    const f32x2 s = (v * v) * (-0.72134752044f);
    f32x2 e; e.x = __builtin_amdgcn_exp2f(s.x); e.y = __builtin_amdgcn_exp2f(s.y);
    const f32x2 m = v * (q * e), r = v - m;
    f32x2 o; o.x = v.x < 0.f ? m.x : r.x; o.y = v.y < 0.f ? m.y : r.y; return o;
}

template <int ACT  > struct EpiBf16 {
    static constexpr bool PERM = true, AFTER_DRAIN = false; static_assert(ACT == 0 || ACT == 1, "EpiBf16: ACT is 0 (none) or 1 (gelu_pk)");
    bf16_t* O; int ldc; const float* bias; int split_cols; size_t split_stride; float scale0;
    __device__ __forceinline__ void operator()(const f32x4 (&acc)[2][2][4][2], const Unit& u, int wr, int wc, int fr, int fq) const {
        const int row0 = u.pm * BM + wr * 64 + fr; int colt = u.pn * BM; bf16_t* base = O;
        float sc = 1.f; if (split_cols) { const int t = colt / split_cols; base += (size_t)t * split_stride; colt -= t * split_cols; if (t == 0) sc = scale0; }
        const int col0 = colt + wc * 32 + 8 * fq, bcol0 = u.pn * BM + wc * 32 + 8 * fq;
        f32x4 bv[2][2];
#pragma unroll
        for (int bj = 0; bj < 2; ++bj)
#pragma unroll
            for (int n = 0; n < 2; ++n) bv[bj][n] = bias ? *(const f32x4*)(bias + bcol0 + bj * HALF + 4 * n) : (f32x4){0.f, 0.f, 0.f, 0.f};
#pragma unroll
        for (int ai = 0; ai < 2; ++ai)
#pragma unroll
            for (int m = 0; m < 4; ++m) { bf16_t* rowp = base + (size_t)(row0 + ai * HALF + m * 16) * ldc + col0;
#pragma unroll
                for (int bj = 0; bj < 2; ++bj) { f32x4 v0 = acc[ai][bj][m][0] + bv[bj][0], v1 = acc[ai][bj][m][1] + bv[bj][1];
                    if (ACT == 1) { f32x2 a = gelu_pk((f32x2){v0[0], v0[1]}), b = gelu_pk((f32x2){v0[2], v0[3]}), c = gelu_pk((f32x2){v1[0], v1[1]}), d = gelu_pk((f32x2){v1[2], v1[3]});
                        v0 = (f32x4){a.x, a.y, b.x, b.y}; v1 = (f32x4){c.x, c.y, d.x, d.y}; }
                    v0 = v0 * sc; v1 = v1 * sc; u32x4 w; w.x = cvt_pk_bf16(v0[0], v0[1]); w.y = cvt_pk_bf16(v0[2], v0[3]); w.z = cvt_pk_bf16(v1[0], v1[1]); w.w = cvt_pk_bf16(v1[2], v1[3]);
                    *(u32x4*)(rowp + bj * HALF) = w; } }
    }
};

struct PanelStats {
    unsigned* xbuf;
    unsigned* cnt;
    unsigned* tmo;
    int ntn; float eps;
    unsigned code;
    __device__ __forceinline__ bool run(const f32x4 (&v)[2][2][4][2], const Unit& u, int wr, int wc, int fr, int fq, PG8_LAS unsigned char* lds, int wid, int lane) const {
        typedef float f32x2v __attribute__((ext_vector_type(2)));
        PG8_LAS f32x2v* P = (PG8_LAS f32x2v*)lds;
        PG8_LAS f32x2v* S = (PG8_LAS f32x2v*)(lds + 8192);
        PG8_LAS unsigned* flag = (PG8_LAS unsigned*)(lds + 8192 + 2048);
#pragma unroll
        for (int ai = 0; ai < 2; ++ai)
#pragma unroll
            for (int m = 0; m < 4; ++m) {
                float s = 0.f;
#pragma unroll
                for (int bj = 0; bj < 2; ++bj)
#pragma unroll
                    for (int n = 0; n < 2; ++n) { const f32x4 x = v[ai][bj][m][n]; s += (x[0] + x[1]) + (x[2] + x[3]); }
                s += __shfl_xor(s, 16); s += __shfl_xor(s, 32);
                const float mw = s * (1.0f / 64.0f); float q = 0.f;
#pragma unroll
                for (int bj = 0; bj < 2; ++bj)
#pragma unroll
                    for (int n = 0; n < 2; ++n) { const f32x4 d = v[ai][bj][m][n] - mw; q += (d[0] * d[0] + d[1] * d[1]) + (d[2] * d[2] + d[3] * d[3]); }
                q += __shfl_xor(q, 16); q += __shfl_xor(q, 32);
                if (fq == 0) P[(ai * HALF + wr * 64 + m * 16 + fr) * 4 + wc] = (f32x2v){mw, q};
            }
        asm volatile("s_waitcnt lgkmcnt(0)" ::: "memory"); __builtin_amdgcn_s_barrier(); asm volatile("" ::: "memory");
#if defined(BROKEN_EXCHANGE_NO_WAIT)
#warning BROKEN CONTROL BUILD: the row-statistics exchange does not wait; results are wrong by design
        if (blockIdx.x >= 64) { const long long t0_ = clock64(); while (clock64() - t0_ < 60000) __builtin_amdgcn_s_sleep(8); }
#endif
        const int row = wid * 32 + (lane & 31);
        if (lane < 32) {
            const f32x2v a = P[row * 4 + 0], b = P[row * 4 + 1], c = P[row * 4 + 2], d = P[row * 4 + 3];
            const float mt = (a.x + b.x + c.x + d.x) * 0.25f;
            const float da = a.x - mt, db = b.x - mt, dc = c.x - mt, dd = d.x - mt;
            const float m2 = (a.y + b.y) + (c.y + d.y) + 64.0f * ((da * da + db * db) + (dc * dc + dd * dd));
            unsigned long long* slot = (unsigned long long*)xbuf + ((size_t)(u.pm * BM + row) * 4 + u.pn);
            __hip_atomic_store(slot, ((unsigned long long)__float_as_uint(m2) << 32) | __float_as_uint(mt), __ATOMIC_RELAXED, __HIP_MEMORY_SCOPE_AGENT);
        }
        asm volatile("s_waitcnt vmcnt(0)" ::: "memory");
        if (lane == 0) __hip_atomic_fetch_add(cnt + 64 * u.pm, 1u, __ATOMIC_RELAXED, __HIP_MEMORY_SCOPE_AGENT);
        if (wid == 0) {
            bool dead = false; const unsigned long long t0 = __builtin_amdgcn_s_memrealtime(); const unsigned want = 8u * (unsigned)ntn;
            for (;;) {
#if defined(BROKEN_EXCHANGE_NO_WAIT)
                break;
#endif
                if ((unsigned)__builtin_amdgcn_readfirstlane(__hip_atomic_load(cnt + 64 * u.pm, __ATOMIC_RELAXED, __HIP_MEMORY_SCOPE_AGENT)) >= want) break;
                if (__builtin_amdgcn_s_memrealtime() - t0 > 2000000ull) {
                    if (lane == 0) { unsigned expect = 0u; __hip_atomic_compare_exchange_strong(tmo + 1, &expect, code | (unsigned)(u.pm & 0xff), __ATOMIC_RELAXED, __ATOMIC_RELAXED, __HIP_MEMORY_SCOPE_AGENT);
                                     __hip_atomic_store(tmo, 1u, __ATOMIC_RELAXED, __HIP_MEMORY_SCOPE_AGENT); }
                    dead = true; break; }
                __builtin_amdgcn_s_sleep(2);
            }
            __builtin_amdgcn_fence(__ATOMIC_ACQUIRE, "agent");
            if (lane == 0) flag[0] = dead ? 1u : 0u;
        }
        asm volatile("s_waitcnt vmcnt(0) lgkmcnt(0)" ::: "memory"); __builtin_amdgcn_s_barrier(); asm volatile("" ::: "memory");
        const bool bad = flag[0] != 0u;
        if (lane < 32) {
            const unsigned long long* slot = (const unsigned long long*)xbuf + (size_t)(u.pm * BM + row) * 4; float mt[4], m2[4]; float ms = 0.f;
#pragma unroll
            for (int t = 0; t < 4; ++t) { if (t < ntn) { const unsigned long long w = __hip_atomic_load(slot + t, __ATOMIC_RELAXED, __HIP_MEMORY_SCOPE_AGENT); mt[t] = __uint_as_float((unsigned)w); m2[t] = __uint_as_float((unsigned)(w >> 32)); } else { mt[t] = 0.f; m2[t] = 0.f; } ms += mt[t]; }
            const float mean = ms / (float)ntn; float q = 0.f;
#pragma unroll
            for (int t = 0; t < 4; ++t) if (t < ntn) { const float dm = mt[t] - mean; q += m2[t] + 256.0f * dm * dm; }
            S[row] = (f32x2v){mean, 1.0f / sqrtf(q / (256.0f * (float)ntn) + eps)};
        }
        asm volatile("s_waitcnt lgkmcnt(0)" ::: "memory"); __builtin_amdgcn_s_barrier(); asm volatile("" ::: "memory");
        return bad;
    }
};
struct EpiLnRes {
    static constexpr bool PERM = false, AFTER_DRAIN = true;
    const float* base; float* out; int ldc; const float* bias; PanelStats st; unsigned poison;
    __device__ __forceinline__ void fused(f32x4 (&acc)[2][2][4][2], const Unit& u, int wr, int wc, int fr, int fq, PG8_LAS unsigned char* lds, int wid, int lane) const {
        typedef float f32x2v __attribute__((ext_vector_type(2)));
        const PG8_LAS f32x2v* S = (const PG8_LAS f32x2v*)(lds + 8192);
        const int col0 = u.pn * BM + wc * 32 + 4 * fq;
#pragma unroll
        for (int bj = 0; bj < 2; ++bj)
#pragma unroll
            for (int n = 0; n < 2; ++n) { const f32x4 bv = bias ? *(const f32x4*)(bias + col0 + bj * HALF + n * 16) : (f32x4){0.f, 0.f, 0.f, 0.f};
#pragma unroll
                for (int ai = 0; ai < 2; ++ai)
#pragma unroll
                    for (int m = 0; m < 4; ++m) acc[ai][bj][m][n] += bv; }
        f32x4 pre[4][2][2];
#pragma unroll
        for (int m = 0; m < 4; ++m) { const size_t off = (size_t)(u.pm * BM + wr * 64 + m * 16 + fr) * ldc + col0;
#pragma unroll
            for (int bj = 0; bj < 2; ++bj)
#pragma unroll
                for (int n = 0; n < 2; ++n) pre[m][bj][n] = *(const f32x4*)(base + off + bj * HALF + n * 16); }
        const bool bad = st.run(acc, u, wr, wc, fr, fq, lds, wid, lane) || poison != 0u;
        const float qnan = __builtin_nanf("");
#pragma unroll
        for (int ai = 0; ai < 2; ++ai)
#pragma unroll
            for (int m = 0; m < 4; ++m) { const int r = ai * HALF + wr * 64 + m * 16 + fr; const f32x2v sr = S[r]; const size_t off = (size_t)(u.pm * BM + r) * ldc + col0;
#pragma unroll
                for (int bj = 0; bj < 2; ++bj)
#pragma unroll
                    for (int n = 0; n < 2; ++n) { const f32x4 bs = ai == 0 ? pre[m][bj][n] : *(const f32x4*)(base + off + bj * HALF + n * 16); f32x4 o = bs + (acc[ai][bj][m][n] - sr.x) * sr.y;
                        if (bad) o = (f32x4){qnan, qnan, qnan, qnan}; *(f32x4*)(out + off + bj * HALF + n * 16) = o; }
                if (m & 1) asm volatile("" ::: "memory"); }
    }
};
struct EpiLnResLn {
    static constexpr bool PERM = false, AFTER_DRAIN = true;
    const float* base; float* out; bf16_t* xn; int ldc; const float* bias; PanelStats st1, st2; unsigned poison;
    __device__ __forceinline__ void fused(f32x4 (&acc)[2][2][4][2], const Unit& u, int wr, int wc, int fr, int fq, PG8_LAS unsigned char* lds, int wid, int lane) const {
        typedef float f32x2v __attribute__((ext_vector_type(2))); typedef unsigned u32x2v __attribute__((ext_vector_type(2)));
        const PG8_LAS f32x2v* S = (const PG8_LAS f32x2v*)(lds + 8192);
        const int col0 = u.pn * BM + wc * 32 + 4 * fq;
#pragma unroll
        for (int bj = 0; bj < 2; ++bj)
#pragma unroll
            for (int n = 0; n < 2; ++n) { const f32x4 bv = bias ? *(const f32x4*)(bias + col0 + bj * HALF + n * 16) : (f32x4){0.f, 0.f, 0.f, 0.f};
#pragma unroll
                for (int ai = 0; ai < 2; ++ai)
#pragma unroll
                    for (int m = 0; m < 4; ++m) acc[ai][bj][m][n] += bv; }
        bool bad = st1.run(acc, u, wr, wc, fr, fq, lds, wid, lane) || poison != 0u;
        const float qnan = __builtin_nanf("");
#pragma unroll
        for (int ai = 0; ai < 2; ++ai)
#pragma unroll
            for (int m = 0; m < 4; ++m) { const int r = ai * HALF + wr * 64 + m * 16 + fr; const f32x2v sr = S[r]; const size_t off = (size_t)(u.pm * BM + r) * ldc + col0;
#pragma unroll
                for (int bj = 0; bj < 2; ++bj)
#pragma unroll
                    for (int n = 0; n < 2; ++n) { const f32x4 bs = *(const f32x4*)(base + off + bj * HALF + n * 16); acc[ai][bj][m][n] = bs + (acc[ai][bj][m][n] - sr.x) * sr.y; }
                asm volatile("" : "+v"(acc[ai][0][m][0]), "+v"(acc[ai][0][m][1]), "+v"(acc[ai][1][m][0]), "+v"(acc[ai][1][m][1]));
                if (m & 1) asm volatile("" ::: "memory"); }
        const bool bad1 = bad;
        bad = st2.run(acc, u, wr, wc, fr, fq, lds, wid, lane) || bad;
#pragma unroll
        for (int ai = 0; ai < 2; ++ai)
#pragma unroll
            for (int m = 0; m < 4; ++m) { const int r = ai * HALF + wr * 64 + m * 16 + fr; const f32x2v sr = S[r]; const size_t off = (size_t)(u.pm * BM + r) * ldc + col0;
#pragma unroll
                for (int bj = 0; bj < 2; ++bj)
#pragma unroll
                    for (int n = 0; n < 2; ++n) { const f32x4 x1 = acc[ai][bj][m][n]; *(f32x4*)(out + off + bj * HALF + n * 16) = bad1 ? (f32x4){qnan, qnan, qnan, qnan} : x1;
                        const f32x4 o = (x1 - sr.x) * sr.y; u32x2v w; w.x = cvt_pk_bf16(o[0], o[1]); w.y = cvt_pk_bf16(o[2], o[3]);
                        if (bad) { w.x = 0x7fc07fc0u; w.y = 0x7fc07fc0u; } *(u32x2v*)(xn + off + bj * HALF + n * 16) = w; }
                asm volatile("" ::: "memory"); }
    }
};

template <class Epi, class Sched, bool ALIGN_EPI = false, bool SP2 = false>
__device__ __forceinline__ void gemm_phase(PG8_LAS unsigned char* lds, const Gemm g, const Sched& S, const Epi& E) {
    int tid_ = threadIdx.x; asm volatile("" : "+v"(tid_));
    const int tid = tid_, wid = __builtin_amdgcn_readfirstlane(tid >> 6), lane = tid & 63, wr = wid >> 2, wc = wid & 3, fr = lane & 15, fq = lane >> 4;
    const int K = g.K, nt = K / BK;
    unsigned voffA[2], voffB[2];
#pragma unroll
    for (int i = 0; i < 2; ++i) { int R, C; stage_rc(tid * 16 + i * 8192, R, C); const int Rb = Epi::PERM ? ((R & ~31) + perm32(R & 31)) : R;
        voffA[i] = (unsigned)(R * K + C) * 2u; voffB[i] = (unsigned)(Rb * K + C) * 2u; }
    const size_t kstep = (size_t)(BK * 2);
    const size_t hstep = (size_t)HALF * K * 2;
    const size_t tstep = 2 * hstep;
    const unsigned ldsw = (unsigned)wid * 1024u;
    const int aoff = lds_byte(wr * 64 + fr, fq * 8), boff = lds_byte(wc * 32 + fr, fq * 8);
#define PG8_SA(b, h) (((b) * 2 + (h)) * HTB)
#define PG8_SB(b, h) ((4 + (b) * 2 + (h)) * HTB)
#define PG8_STAGE(bufoff, gbase, voff) do { _Pragma("unroll") for (int _i = 0; _i < 2; ++_i) \
        __builtin_amdgcn_global_load_lds((const unsigned*)((const char*)(gbase) + (voff)[_i]), (PG8_LAS unsigned*)(lds + (bufoff) + ldsw + _i * 8192), 16, 0, 0); } while (0)
#define PG8_LDA(dst, b, h) do { _Pragma("unroll") for (int m = 0; m < 4; ++m) _Pragma("unroll") for (int k = 0; k < 2; ++k) dst[m][k] = *(const PG8_LAS bf16x8*)(lds + PG8_SA(b, h) + aoff + m * 2048 + k * 1024); } while (0)
#define PG8_LDB(dst, b, h) do { _Pragma("unroll") for (int n = 0; n < 2; ++n) _Pragma("unroll") for (int k = 0; k < 2; ++k) dst[n][k] = *(const PG8_LAS bf16x8*)(lds + PG8_SB(b, h) + boff + n * 2048 + k * 1024); } while (0)
#define PG8_MMA(ai, bj, At, Bt) do { __builtin_amdgcn_s_setprio(1); _Pragma("unroll") for (int m = 0; m < 4; ++m) _Pragma("unroll") for (int n = 0; n < 2; ++n) _Pragma("unroll") for (int k = 0; k < 2; ++k) \
        acc[ai][bj][m][n] = __builtin_amdgcn_mfma_f32_16x16x32_bf16(Bt[n][k], At[m][k], acc[ai][bj][m][n], 0, 0, 0); __builtin_amdgcn_s_setprio(0); } while (0)
#define PG8_WAIT_V(n) asm volatile("s_waitcnt vmcnt(" #n ")" ::: "memory")
#define PG8_WAIT_L(n) asm volatile("s_waitcnt lgkmcnt(" #n ")" ::: "memory")
#define PG8_BAR __builtin_amdgcn_s_barrier()
#define PG8_SCHED __builtin_amdgcn_sched_barrier(0)
    Unit cur, nxt; int ui = 0;
    if (!S.next(0, cur)) return;
    f32x4 acc[2][2][4][2];
#pragma unroll
    for (int a = 0; a < 2; ++a)
#pragma unroll
        for (int b = 0; b < 2; ++b)
#pragma unroll
            for (int m = 0; m < 4; ++m)
#pragma unroll
                for (int n = 0; n < 2; ++n) acc[a][b][m][n] = (f32x4){0.f, 0.f, 0.f, 0.f};
    bf16x8 At[4][2], B0[2][2], B1[2][2];
    const char* cA = (const char*)g.A + (size_t)cur.pm * tstep; const char* cB = (const char*)g.Bt + (size_t)cur.pn * tstep;
    S.a_ready(cur);
    if constexpr (SP2) {
        PG8_STAGE(PG8_SB(0, 0), cB, voffB); PG8_STAGE(PG8_SB(0, 1), cB + hstep, voffB); PG8_STAGE(PG8_SA(0, 0), cA, voffA); PG8_STAGE(PG8_SA(0, 1), cA + hstep, voffA);
        if (wr == 1) PG8_BAR;
        PG8_WAIT_V(2); PG8_BAR;
        PG8_STAGE(PG8_SB(1, 0), cB + kstep, voffB); PG8_STAGE(PG8_SA(1, 0), cA + kstep, voffA); PG8_STAGE(PG8_SB(1, 1), cB + hstep + kstep, voffB);
        PG8_WAIT_V(6); PG8_BAR;
    } else {
        PG8_STAGE(PG8_SB(0, 0), cB, voffB); PG8_STAGE(PG8_SA(0, 0), cA, voffA); PG8_STAGE(PG8_SB(0, 1), cB + hstep, voffB); PG8_STAGE(PG8_SA(0, 1), cA + hstep, voffA);
        if (wr == 1) PG8_BAR;
        PG8_WAIT_V(4); PG8_BAR;
        PG8_STAGE(PG8_SB(1, 0), cB + kstep, voffB); PG8_STAGE(PG8_SA(1, 0), cA + kstep, voffA); PG8_STAGE(PG8_SB(1, 1), cB + hstep + kstep, voffB);
        PG8_WAIT_V(6); PG8_BAR;
    }
    for (;;) {
        const bool has_next = S.next(ui + 1, nxt);
        const char* nA = has_next ? (const char*)g.A + (size_t)nxt.pm * tstep : cA; const char* nB = has_next ? (const char*)g.Bt + (size_t)nxt.pn * tstep : cB;
        for (int t = 0; t < nt; t += 2) {
            const bool last = (t == nt - 2);
            const char* a1 = cA + (size_t)(t + 1) * kstep;
            const char* a2 = last ? nA : cA + (size_t)(t + 2) * kstep; const char* b2 = last ? nB : cB + (size_t)(t + 2) * kstep;
            const char* a3 = a2 + kstep; const char* b3 = b2 + kstep;
            if (last && has_next) S.a_ready(nxt);
            if constexpr (SP2) {
            PG8_LDB(B0, 0, 0); PG8_LDB(B1, 0, 1); PG8_SCHED; PG8_LDA(At, 0, 0); PG8_STAGE(PG8_SA(1, 1), a1 + hstep, voffA);
            PG8_WAIT_V(8); PG8_WAIT_L(0); PG8_BAR; PG8_MMA(0, 0, At, B0); PG8_MMA(0, 1, At, B1); PG8_BAR; PG8_SCHED;
            PG8_LDA(At, 0, 1); PG8_STAGE(PG8_SB(0, 0), b2, voffB); PG8_STAGE(PG8_SB(0, 1), b2 + hstep, voffB); PG8_STAGE(PG8_SA(0, 0), a2, voffA);
            PG8_WAIT_V(8); PG8_WAIT_L(0); PG8_BAR; PG8_MMA(1, 0, At, B0); PG8_MMA(1, 1, At, B1); PG8_BAR; PG8_SCHED;
            PG8_LDB(B0, 1, 0); PG8_LDB(B1, 1, 1); PG8_SCHED; PG8_LDA(At, 1, 0); PG8_STAGE(PG8_SA(0, 1), a2 + hstep, voffA);
            PG8_WAIT_V(8); PG8_WAIT_L(0); PG8_BAR; PG8_MMA(0, 0, At, B0); PG8_MMA(0, 1, At, B1); PG8_BAR; PG8_SCHED;
            PG8_LDA(At, 1, 1); PG8_STAGE(PG8_SB(1, 0), b3, voffB); PG8_STAGE(PG8_SB(1, 1), b3 + hstep, voffB); PG8_STAGE(PG8_SA(1, 0), a3, voffA);
            PG8_WAIT_V(8); PG8_WAIT_L(0); PG8_BAR; PG8_MMA(1, 0, At, B0); PG8_MMA(1, 1, At, B1); PG8_BAR; PG8_SCHED;
            } else {
            PG8_LDB(B0, 0, 0); PG8_SCHED; PG8_LDA(At, 0, 0); PG8_STAGE(PG8_SA(1, 1), a1 + hstep, voffA);
            PG8_WAIT_L(8); PG8_BAR; PG8_WAIT_L(0); PG8_MMA(0, 0, At, B0); PG8_BAR; PG8_SCHED;
            PG8_LDB(B1, 0, 1); PG8_STAGE(PG8_SB(0, 0), b2, voffB);
            PG8_BAR; PG8_WAIT_L(0); PG8_MMA(0, 1, At, B1); PG8_BAR;
            PG8_LDA(At, 0, 1); PG8_STAGE(PG8_SA(0, 0), a2, voffA);
            PG8_BAR; PG8_WAIT_L(0); PG8_MMA(1, 0, At, B0); PG8_BAR; PG8_SCHED;
            PG8_STAGE(PG8_SB(0, 1), b2 + hstep, voffB);
            PG8_WAIT_V(6); PG8_BAR; PG8_MMA(1, 1, At, B1); PG8_BAR;
            PG8_LDB(B0, 1, 0); PG8_SCHED; PG8_LDA(At, 1, 0); PG8_STAGE(PG8_SA(0, 1), a2 + hstep, voffA);
            PG8_WAIT_L(8); PG8_BAR; PG8_WAIT_L(0); PG8_MMA(0, 0, At, B0); PG8_BAR; PG8_SCHED;
            PG8_LDB(B1, 1, 1); PG8_STAGE(PG8_SB(1, 0), b3, voffB);
            PG8_BAR; PG8_WAIT_L(0); PG8_MMA(0, 1, At, B1); PG8_BAR;
            PG8_LDA(At, 1, 1); PG8_STAGE(PG8_SA(1, 0), a3, voffA);
            PG8_BAR; PG8_WAIT_L(0); PG8_MMA(1, 0, At, B0); PG8_BAR; PG8_SCHED;
            PG8_STAGE(PG8_SB(1, 1), b3 + hstep, voffB);
            PG8_WAIT_V(6); PG8_BAR; PG8_MMA(1, 1, At, B1); PG8_BAR;
            }
        }
        if constexpr (ALIGN_EPI) { if (wr == 0) PG8_BAR; }
        if constexpr (!Epi::AFTER_DRAIN) { E(acc, cur, wr, wc, fr, fq); S.done(cur); }
        if (!has_next) break;
#pragma unroll
        for (int a = 0; a < 2; ++a)
#pragma unroll
            for (int b = 0; b < 2; ++b)
#pragma unroll
                for (int m = 0; m < 4; ++m)
#pragma unroll
                    for (int n = 0; n < 2; ++n) acc[a][b][m][n] = (f32x4){0.f, 0.f, 0.f, 0.f};
        cur = nxt; cA = nA; cB = nB; ++ui;
        if constexpr (ALIGN_EPI) { if (wr == 1) PG8_BAR; }
    }
    PG8_WAIT_V(0);
    if constexpr (!ALIGN_EPI) { if (wr == 0) PG8_BAR; }
    PG8_BAR;
    if constexpr (Epi::AFTER_DRAIN) { E.fused(acc, cur, wr, wc, fr, fq, lds, wid, lane); S.done(cur); }
#undef PG8_SA
#undef PG8_SB
#undef PG8_STAGE
#undef PG8_LDA
#undef PG8_LDB
#undef PG8_MMA
#undef PG8_WAIT_V
#undef PG8_WAIT_L
#undef PG8_BAR
#undef PG8_SCHED
}
}

#include <hip/hip_cooperative_groups.h>
namespace cg = cooperative_groups;

#define GAS __attribute__((address_space(1)))
#define LAS __attribute__((address_space(3)))
typedef unsigned short bf16;
typedef unsigned v4u __attribute__((ext_vector_type(4)));
typedef unsigned v2u __attribute__((ext_vector_type(2)));
typedef unsigned u32x4w __attribute__((ext_vector_type(4)));
typedef float f32x4 __attribute__((ext_vector_type(4)));
typedef short bf16x8 __attribute__((ext_vector_type(8)));
#define LDS_WAIT() asm volatile("s_waitcnt lgkmcnt(0)" ::: "memory")

constexpr int BATCH = 2, SEQ = 16384, D = 1024, M = BATCH * SEQ, NIN = 3584, FF = 4096, DEPTH = 2;
constexpr int HW = 512;
constexpr float ALPHA = 1.4142135623730951f;
constexpr float LN_EPS = 1e-5f, RMS_EPS = 1e-6f;
constexpr size_t MiB = 1u << 20;
constexpr size_t WS_W = 0;
constexpr size_t W_LAYER = 25 * MiB, W_IN = 0, W_O = 7 * MiB, W_1 = 9 * MiB, W_2 = 17 * MiB;
constexpr size_t WS_XB = 52 * MiB;
constexpr size_t WS_A = 116 * MiB;
constexpr size_t SEG_BYTES = 32 * MiB;
constexpr size_t WS_LF = WS_A + 6 * SEG_BYTES;
constexpr size_t WS_B = 372 * MiB;
constexpr size_t WS_ORAW = WS_B + 64 * MiB;
constexpr size_t WS_ML = 500 * MiB;
constexpr size_t WS_END = 506 * MiB;
constexpr int LDS_BYTES = 131072 + 2048;
constexpr int NWAVES = 8;

__device__ __forceinline__ unsigned f2bf(float f) { unsigned u = __builtin_bit_cast(unsigned, f); return (u + 0x7fffu + ((u >> 16) & 1u)) >> 16; }
__device__ __forceinline__ unsigned pk2(float lo, float hi) { return f2bf(lo) | (f2bf(hi) << 16); }
__device__ __forceinline__ float bf2f(unsigned short h) { return __builtin_bit_cast(float, (unsigned)h << 16); }
__device__ __forceinline__ float bflo(unsigned w) { return __builtin_bit_cast(float, w << 16); }
__device__ __forceinline__ float bfhi(unsigned w) { return __builtin_bit_cast(float, w & 0xffff0000u); }
__device__ __forceinline__ float wave_sum(float v) {
#pragma unroll
    for (int o = 1; o < 64; o <<= 1) v += __shfl_xor(v, o);
    return v;
}
__device__ __forceinline__ float wave_max(float v) {
#pragma unroll
    for (int o = 1; o < 64; o <<= 1) v = fmaxf(v, __shfl_xor(v, o));
    return v;
}

namespace pg8 {
struct EpiInProj {
    static constexpr bool PERM = true, AFTER_DRAIN = false;
    bf16_t* seg; float* lf; const float* lb0; const float* lb1; int layer;
    __device__ __forceinline__ void operator()(const f32x4 (&acc)[2][2][4][2], const Unit& u, int wr, int wc, int fr, int fq) const {
        const int t = u.pn >> 1;
        int row0 = u.pm * BM + wr * 64 + fr;
        int cs0 = (u.pn & 1) * 256 + wc * 32 + 8 * fq; asm volatile("" : "+v"(row0), "+v"(cs0));
        if (t == 1) {
#pragma unroll
            for (int bj = 0; bj < 2; ++bj) {
                float lbv[8];
#pragma unroll
                for (int i = 0; i < 8; ++i) { const int c = cs0 + bj * HALF + i; lbv[i] = layer ? 1.0f / (1.0f + __expf(-(lb1[c] - lb0[c]))) : 0.0f; }
#pragma unroll
                for (int ai = 0; ai < 2; ++ai)
#pragma unroll
                    for (int m = 0; m < 4; ++m) {
                        float* p = lf + (size_t)(row0 + ai * HALF + m * 16) * 512 + cs0 + bj * HALF;
                        f32x4 o[2];
#pragma unroll
                        for (int n = 0; n < 2; ++n)
#pragma unroll
                            for (int e = 0; e < 4; ++e) { const float z = acc[ai][bj][m][n][e]; const float sg = 1.0f / (1.0f + __expf(-z)); const float lb = lbv[n * 4 + e]; o[n][e] = __logf(lb + (1.0f - lb) * sg); }
                        *(f32x4*)p = o[0]; *(f32x4*)(p + 4) = o[1]; asm volatile("" ::: "memory");
                    }
            }
        } else {
            const int di = t == 0 ? 0 : t - 1;
            bf16_t* base = seg + (size_t)di * ((size_t)32 * 1024 * 1024 / 2);
#pragma unroll
            for (int ai = 0; ai < 2; ++ai)
#pragma unroll
                for (int m = 0; m < 4; ++m)
#pragma unroll
                    for (int bj = 0; bj < 2; ++bj) {
                        float v[8];
#pragma unroll
                        for (int n = 0; n < 2; ++n)
#pragma unroll
                            for (int e = 0; e < 4; ++e) { float z = acc[ai][bj][m][n][e];
                                if (t == 0) z = z / (1.0f + __expf(-z));
                                else if (t == 3) z = 1.0f / (1.0f + __expf(-z));
                                else if (t == 4) z = z * 0.18033688011112042f;
                                v[n * 4 + e] = z; }
                        u32x4 w; w.x = cvt_pk_bf16(v[0], v[1]); w.y = cvt_pk_bf16(v[2], v[3]); w.z = cvt_pk_bf16(v[4], v[5]); w.w = cvt_pk_bf16(v[6], v[7]);
                        *(u32x4*)(base + (size_t)(row0 + ai * HALF + m * 16) * 512 + cs0 + bj * HALF) = w;
                    }
        }
    }
};
struct EpiResid {
    static constexpr bool PERM = true, AFTER_DRAIN = false;
    const float* res; float* out; float alpha;
    __device__ __forceinline__ void operator()(const f32x4 (&acc)[2][2][4][2], const Unit& u, int wr, int wc, int fr, int fq) const {
        int row0 = u.pm * BM + wr * 64 + fr; int col0 = u.pn * BM + wc * 32 + 8 * fq; asm volatile("" : "+v"(row0), "+v"(col0));
#pragma unroll
        for (int ai = 0; ai < 2; ++ai)
#pragma unroll
            for (int m = 0; m < 4; ++m)
#pragma unroll
                for (int bj = 0; bj < 2; ++bj) {
                    const size_t off = (size_t)(row0 + ai * HALF + m * 16) * 1024 + col0 + bj * HALF;
                    const f32x4 r0 = *(const f32x4*)(res + off), r1 = *(const f32x4*)(res + off + 4);
                    *(f32x4*)(out + off) = r0 * alpha + acc[ai][bj][m][0]; *(f32x4*)(out + off + 4) = r1 * alpha + acc[ai][bj][m][1];
                    if (bj == 1) asm volatile("" ::: "memory");
                }
    }
};
struct EpiSqRelu {
    static constexpr bool PERM = true, AFTER_DRAIN = false;
    bf16_t* out;
    __device__ __forceinline__ void operator()(const f32x4 (&acc)[2][2][4][2], const Unit& u, int wr, int wc, int fr, int fq) const {
        int row0 = u.pm * BM + wr * 64 + fr; int col0 = u.pn * BM + wc * 32 + 8 * fq; asm volatile("" : "+v"(row0), "+v"(col0));
#pragma unroll
        for (int ai = 0; ai < 2; ++ai)
#pragma unroll
            for (int m = 0; m < 4; ++m)
#pragma unroll
                for (int bj = 0; bj < 2; ++bj) {
                    f32x4 a = acc[ai][bj][m][0], b = acc[ai][bj][m][1];
#pragma unroll
                    for (int e = 0; e < 4; ++e) { a[e] = fmaxf(a[e], 0.f); a[e] *= a[e]; b[e] = fmaxf(b[e], 0.f); b[e] *= b[e]; }
                    u32x4 w; w.x = cvt_pk_bf16(a[0], a[1]); w.y = cvt_pk_bf16(a[2], a[3]); w.z = cvt_pk_bf16(b[0], b[1]); w.w = cvt_pk_bf16(b[2], b[3]);
                    *(u32x4*)(out + (size_t)(row0 + ai * HALF + m * 16) * 4096 + col0 + bj * HALF) = w;
                }
    }
};
}

__device__ __forceinline__ void p0_transpose_item(const float* W, int K, int N, bf16* WT, LAS float* scr, int item, int lane) {
    asm volatile("" : "+v"(lane));
    const int nblk = N / 32, kb = item / nblk, nb = item % nblk, k0 = 64 * kb, n0 = 32 * nb;
#pragma unroll 8
    for (int i = 0; i < 32; ++i) { const int kk = 2 * i + (lane >> 5); scr[kk * 33 + (lane & 31)] = W[(size_t)(k0 + kk) * N + n0 + (lane & 31)]; }
    LDS_WAIT(); asm volatile("" ::: "memory");
    const int c = lane & 7;
#pragma unroll
    for (int j = 0; j < 4; ++j) { const int n = (lane >> 3) + 8 * j; const LAS float* s = scr + (8 * c) * 33 + n;
        v4u o; o.x = pk2(s[0 * 33], s[1 * 33]); o.y = pk2(s[2 * 33], s[3 * 33]); o.z = pk2(s[4 * 33], s[5 * 33]); o.w = pk2(s[6 * 33], s[7 * 33]);
        *(GAS v4u*)(WT + (size_t)(n0 + n) * K + k0 + 8 * c) = o; }
    LDS_WAIT(); asm volatile("" ::: "memory");
}

struct Args { const float* in[11]; float* out; unsigned char* ws; };

__device__ __forceinline__ void ln_rows(const float* src, float* dst, bf16* xb, const float* g, const float* b, int gw, int NGW, int lane) {
    asm volatile("" : "+v"(lane));
    f32x4 gv[4], bv[4];
#pragma unroll
    for (int j = 0; j < 4; ++j) { gv[j] = *((const f32x4*)g + lane + 64 * j); bv[j] = *((const f32x4*)b + lane + 64 * j); }
    for (int m = gw; m < M; m += NGW) {
        const f32x4* xr = (const f32x4*)(src + (size_t)m * D) + lane;
        f32x4 v[4]; float s = 0.f;
#pragma unroll
        for (int j = 0; j < 4; ++j) { v[j] = xr[64 * j]; s += (v[j].x + v[j].y) + (v[j].z + v[j].w); }
        const float mean = wave_sum(s) * (1.f / D); float s2 = 0.f;
#pragma unroll
        for (int j = 0; j < 4; ++j) { v[j] = v[j] - mean; s2 += (v[j].x * v[j].x + v[j].y * v[j].y) + (v[j].z * v[j].z + v[j].w * v[j].w); }
        const float rstd = 1.f / sqrtf(wave_sum(s2) * (1.f / D) + LN_EPS);
        f32x4* o4 = (f32x4*)(dst + (size_t)m * D) + lane;
        v2u* o8 = (v2u*)(xb + (size_t)m * D) + lane;
#pragma unroll
        for (int j = 0; j < 4; ++j) { const f32x4 y = v[j] * rstd * gv[j] + bv[j]; o4[64 * j] = y; v2u w; w.x = pk2(y.x, y.y); w.y = pk2(y.z, y.w); o8[64 * j] = w; }
    }
}

__device__ __forceinline__ void hgrn_simple(const bf16* QS, const float* LF, const bf16* VI, float* ORAW, int gw, int lane) {
    asm volatile("" : "+v"(lane));
    if (gw >= BATCH * 4 * 128) return;
    const int b = gw >> 9, h = (gw >> 7) & 3, v = gw & 127;
    float S0 = 0.f, S1 = 0.f;
    const size_t rb = (size_t)b * SEQ;
    for (int t0 = 0; t0 < SEQ; t0 += 16) {
        float lf0[16], lf1[16], q0[16], q1[16], vv[16];
#pragma unroll
        for (int i = 0; i < 16; ++i) { const size_t o = (rb + t0 + i) * 512 + h * 128;
            lf0[i] = LF[o + lane]; lf1[i] = LF[o + 64 + lane]; q0[i] = bf2f(QS[o + lane]); q1[i] = bf2f(QS[o + 64 + lane]); vv[i] = bf2f(VI[o + v]); }
        float res = 0.f;
#pragma unroll
        for (int i = 0; i < 16; ++i) {
            const float f0 = __expf(lf0[i]), f1 = __expf(lf1[i]);
            S0 = f0 * S0 + (1.f - f0) * vv[i]; S1 = f1 * S1 + (1.f - f1) * vv[i];
            const float p = wave_sum(q0[i] * S0 + q1[i] * S1);
            if (lane == i) res = p;
        }
        if (lane < 16) ORAW[(rb + t0 + lane) * 512 + h * 128 + v] = res;
    }
}
__device__ __forceinline__ void hgrn_finalize(const float* ORAW, const bf16* GT, const float* nw, bf16* O, int gw, int NGW, int lane) {
    asm volatile("" : "+v"(lane));
    for (int it = gw; it < M * 4; it += NGW) {
        const int row = it >> 2, h = it & 3; const size_t o = (size_t)row * 512 + h * 128 + 2 * lane;
        const float a = ORAW[o], c = ORAW[o + 1];
        const float ss = wave_sum(a * a + c * c);
        const float r = 1.0f / sqrtf(ss * (1.f / 128.f) + RMS_EPS);
        const unsigned gt = *(const unsigned*)(GT + o);
        const float y0 = a * r * nw[h * 128 + 2 * lane] * bflo(gt), y1 = c * r * nw[h * 128 + 2 * lane + 1] * bfhi(gt);
        *(unsigned*)(O + (size_t)row * D + h * 128 + 2 * lane) = pk2(y0, y1);
    }
}
__device__ __forceinline__ float dot8(v4u a, v4u b) {
    return bflo(a.x) * bflo(b.x) + bfhi(a.x) * bfhi(b.x) + bflo(a.y) * bflo(b.y) + bfhi(a.y) * bfhi(b.y) + bflo(a.z) * bflo(b.z) + bfhi(a.z) * bfhi(b.z) + bflo(a.w) * bflo(b.w) + bfhi(a.w) * bfhi(b.w);
}
__device__ __forceinline__ void attn_simple(const bf16* AQ, const bf16* AK, const bf16* AV, bf16* O, LAS float* pbuf, int gw, int NGW, int lane) {
    asm volatile("" : "+v"(lane));
    for (int it = gw; it < M * 8; it += NGW) {
        const int row = it >> 3, h = it & 7, b = row / SEQ, t = row % SEQ;
        const v4u* qp = (const v4u*)(AQ + (size_t)row * 512 + h * 64);
        v4u q[8];
#pragma unroll
        for (int i = 0; i < 8; ++i) q[i] = qp[i];
        float sc[6]; float mx = -INFINITY;
#pragma unroll
        for (int p = 0; p < 3; ++p) { const int d = p == 0 ? 1 : (p == 1 ? 4 : 16);
#pragma unroll
            for (int c = 0; c < 2; ++c) { const int j = 1 + 64 * c + lane; const int s = t - j * d; float a = -INFINITY;
                if (s >= 0) { const v4u* kp = (const v4u*)(AK + ((size_t)b * SEQ + s) * 512 + h * 64); a = 0.f;
#pragma unroll
                    for (int i = 0; i < 8; ++i) a += dot8(q[i], kp[i]); }
                sc[p * 2 + c] = a; mx = fmaxf(mx, a); } }
        float sself = 0.f; { const v4u* kp = (const v4u*)(AK + (size_t)row * 512 + h * 64);
#pragma unroll
            for (int i = 0; i < 8; ++i) sself += dot8(q[i], kp[i]); }
        mx = fmaxf(wave_max(mx), sself);
        float l = 0.f;
#pragma unroll
        for (int i = 0; i < 6; ++i) { const float e = __expf(sc[i] - mx); pbuf[i * 64 + lane] = e; l += e; }
        const float pself = 3.0f * __expf(sself - mx);
        l = wave_sum(l) + pself;
        LDS_WAIT(); asm volatile("" ::: "memory");
        float o = pself * bf2f(AV[(size_t)row * 512 + h * 64 + lane]);
#pragma unroll
        for (int p = 0; p < 3; ++p) { const int d = p == 0 ? 1 : (p == 1 ? 4 : 16);
            int jmax = t / d; if (jmax > 128) jmax = 128;
#pragma unroll 8
            for (int j = 1; j <= jmax; ++j) o += pbuf[p * 128 + j - 1] * bf2f(AV[((size_t)b * SEQ + t - j * d) * 512 + h * 64 + lane]);
        }
        O[(size_t)row * D + 512 + h * 64 + lane] = (bf16)f2bf(o / l);
        LDS_WAIT(); asm volatile("" ::: "memory");
    }
}

typedef float f32x16 __attribute__((ext_vector_type(16)));
typedef short v4i16_t __attribute__((ext_vector_type(4)));
constexpr int IMG_STRIDE = 16384 + 64, VHALF_BYTES = 2 * IMG_STRIDE;
__device__ __forceinline__ int crow(int r, int hi) { return (r & 3) + 8 * (r >> 2) + 4 * hi; }
__device__ __forceinline__ void attn_mfma(const bf16* AQ, const bf16* AK, const bf16* AV, bf16* O, bf16* XBp, float* ML, LAS unsigned char* L, int tid) {
    asm volatile("" : "+v"(tid));
    const int lane = tid & 63, wave = __builtin_amdgcn_readfirstlane(tid >> 6), half = wave >> 2, qi = wave & 3, l31 = lane & 31, hi = lane >> 5, ti = tid & 255;
    LAS unsigned char* Vimg = L + half * VHALF_BYTES;
    const int G = gridDim.x;
    for (int pair = blockIdx.x; pair < 3072; pair += G) {
        const int it = pair * 2 + half;
        const int bh = it / 384, rem = it - bh * 384, p = rem >> 7, c = rem & 127, sh = 2 * p, dil = 1 << sh, r = c & (dil - 1), n = c >> sh;
        const int b = bh >> 3, h = bh & 7;
        const size_t rowbase = (size_t)b * SEQ;
        __syncthreads();
#pragma unroll
        for (int k = 0; k < 8; ++k) {
            const int cid = ti + 256 * k, j = cid >> 3, cc = cid & 7; int m = 128 * (n - 1) + j; m = m < 0 ? 0 : m;
            const v4u v = *(const v4u*)(AV + (rowbase + (size_t)(m * dil + r)) * 512 + h * 64 + 8 * cc);
            *(LAS v4u*)(Vimg + (cc >> 2) * IMG_STRIDE + j * 64 + (cc & 3) * 16) = v;
        }
        const size_t qrow = rowbase + (size_t)((128 * n + 32 * qi + l31) * dil + r);
        bf16x8 qf[4];
        { const bf16x8* qp = (const bf16x8*)(AQ + qrow * 512 + h * 64 + 32 * hi);
#pragma unroll
          for (int ks = 0; ks < 4; ++ks) qf[ks] = qp[ks]; }
        f32x16 S[5];
#pragma unroll
        for (int kk = 0; kk < 5; ++kk) {
            int m = 128 * (n - 1) + 32 * (qi + kk) + l31; m = m < 0 ? 0 : m;
            const bf16x8* kp = (const bf16x8*)(AK + (rowbase + (size_t)(m * dil + r)) * 512 + h * 64 + 32 * hi);
            bf16x8 kf[4];
#pragma unroll
            for (int ks = 0; ks < 4; ++ks) kf[ks] = kp[ks];
            f32x16 a = {};
#pragma unroll
            for (int ks = 0; ks < 4; ++ks) a = __builtin_amdgcn_mfma_f32_32x32x16_bf16(kf[ks], qf[ks], a, 0, 0, 0);
            S[kk] = a;
        }
        float mx = -INFINITY;
#pragma unroll
        for (int kk = 0; kk < 5; ++kk)
#pragma unroll
            for (int jj = 0; jj < 16; ++jj) { const int kl = crow(jj, hi), jrel = 32 * kk + kl - l31;
                const bool valid = jrel >= 0 && jrel <= 128 && (n > 0 || 32 * (qi + kk) + kl >= 128);
                const float sv = valid ? S[kk][jj] : -INFINITY; S[kk][jj] = sv; mx = fmaxf(mx, sv); }
        mx = fmaxf(mx, __shfl_xor(mx, 32));
        float lsum = 0.f;
#pragma unroll
        for (int kk = 0; kk < 5; ++kk)
#pragma unroll
            for (int jj = 0; jj < 16; ++jj) { const float e = __builtin_amdgcn_exp2f(S[kk][jj] - mx); S[kk][jj] = e; lsum += e; }
        lsum += __shfl_xor(lsum, 32);
        __syncthreads();
        f32x16 o0 = {}, o1 = {};
        const int g = lane >> 4, q4 = (lane & 15) >> 2, p4 = lane & 3;
        const LAS unsigned char* vb = Vimg + (4 * (g >> 1) + q4) * 64 + (16 * (g & 1) + 4 * p4) * 2;
#pragma unroll
        for (int kk = 0; kk < 5; ++kk)
#pragma unroll
            for (int s2 = 0; s2 < 2; ++s2) {
                u32x4w pw; pw.x = pk2(S[kk][8 * s2 + 0], S[kk][8 * s2 + 1]); pw.y = pk2(S[kk][8 * s2 + 2], S[kk][8 * s2 + 3]); pw.z = pk2(S[kk][8 * s2 + 4], S[kk][8 * s2 + 5]); pw.w = pk2(S[kk][8 * s2 + 6], S[kk][8 * s2 + 7]);
                const bf16x8 pf = __builtin_bit_cast(bf16x8, pw);
                const LAS unsigned char* vk = vb + (32 * (qi + kk) + 16 * s2) * 64;
                const v4i16_t a00 = __builtin_amdgcn_ds_read_tr16_b64_v4i16((LAS v4i16_t*)(vk)), a01 = __builtin_amdgcn_ds_read_tr16_b64_v4i16((LAS v4i16_t*)(vk + 8 * 64));
                const v4i16_t a10 = __builtin_amdgcn_ds_read_tr16_b64_v4i16((LAS v4i16_t*)(vk + IMG_STRIDE)), a11 = __builtin_amdgcn_ds_read_tr16_b64_v4i16((LAS v4i16_t*)(vk + IMG_STRIDE + 8 * 64));
                const bf16x8 v0 = {a00[0], a00[1], a00[2], a00[3], a01[0], a01[1], a01[2], a01[3]}, v1 = {a10[0], a10[1], a10[2], a10[3], a11[0], a11[1], a11[2], a11[3]};
                o0 = __builtin_amdgcn_mfma_f32_32x32x16_bf16(v0, pf, o0, 0, 0, 0);
                o1 = __builtin_amdgcn_mfma_f32_32x32x16_bf16(v1, pf, o1, 0, 0, 0);
            }
        bf16* ob = p == 0 ? O + qrow * 1024 + 512 + h * 64 : XBp + (size_t)(p - 1) * ((size_t)M * 512) + qrow * 512 + h * 64;
#pragma unroll
        for (int g4 = 0; g4 < 4; ++g4) {
            v2u w0; w0.x = pk2(o0[4 * g4], o0[4 * g4 + 1]); w0.y = pk2(o0[4 * g4 + 2], o0[4 * g4 + 3]); *(v2u*)(ob + 8 * g4 + 4 * hi) = w0;
            v2u w1; w1.x = pk2(o1[4 * g4], o1[4 * g4 + 1]); w1.y = pk2(o1[4 * g4 + 2], o1[4 * g4 + 3]); *(v2u*)(ob + 32 + 8 * g4 + 4 * hi) = w1;
        }
        if (hi == 0) { float* mlp = ML + (((size_t)p * M + qrow) * 8 + h) * 2; mlp[0] = mx; mlp[1] = lsum; }
    }
}
__device__ __forceinline__ void attn_merge(bf16* O, const bf16* XBp, const float* ML, int gw, int NGW, int lane) {
    asm volatile("" : "+v"(lane));
    const int hh = lane >> 3, c8 = lane & 7;
    for (int row = gw; row < M; row += NGW) {
        float m[3], l[3];
#pragma unroll
        for (int p = 0; p < 3; ++p) { const float* mlp = ML + (((size_t)p * M + row) * 8 + hh) * 2; m[p] = mlp[0]; l[p] = mlp[1]; }
        const float ma = fmaxf(m[0], fmaxf(m[1], m[2]));
        float w[3], den = 0.f;
#pragma unroll
        for (int p = 0; p < 3; ++p) { w[p] = __builtin_amdgcn_exp2f(m[p] - ma); den += w[p] * l[p]; }
        const float inv = 1.0f / den;
        bf16* op = O + (size_t)row * 1024 + 512 + hh * 64 + 8 * c8;
        const v4u a = *(const v4u*)op, b1 = *(const v4u*)(XBp + (size_t)row * 512 + hh * 64 + 8 * c8), b2 = *(const v4u*)(XBp + (size_t)M * 512 + (size_t)row * 512 + hh * 64 + 8 * c8);
        v4u r;
        r.x = pk2((w[0] * bflo(a.x) + w[1] * bflo(b1.x) + w[2] * bflo(b2.x)) * inv, (w[0] * bfhi(a.x) + w[1] * bfhi(b1.x) + w[2] * bfhi(b2.x)) * inv);
        r.y = pk2((w[0] * bflo(a.y) + w[1] * bflo(b1.y) + w[2] * bflo(b2.y)) * inv, (w[0] * bfhi(a.y) + w[1] * bfhi(b1.y) + w[2] * bfhi(b2.y)) * inv);
        r.z = pk2((w[0] * bflo(a.z) + w[1] * bflo(b1.z) + w[2] * bflo(b2.z)) * inv, (w[0] * bfhi(a.z) + w[1] * bfhi(b1.z) + w[2] * bfhi(b2.z)) * inv);
        r.w = pk2((w[0] * bflo(a.w) + w[1] * bflo(b1.w) + w[2] * bflo(b2.w)) * inv, (w[0] * bfhi(a.w) + w[1] * bfhi(b1.w) + w[2] * bfhi(b2.w)) * inv);
        *(v4u*)op = r;
    }
}

__global__ void __launch_bounds__(512, 2) fwd_mega(Args args) {
    extern __shared__ __attribute__((aligned(16))) unsigned char lds[];
    cg::grid_group grid = cg::this_grid();
    LAS unsigned char* L = (LAS unsigned char*)lds;
    const int tid = threadIdx.x, lane = tid & 63, wave = __builtin_amdgcn_readfirstlane(tid >> 6);
    const int G = gridDim.x, gw = blockIdx.x * NWAVES + wave, NGW = G * NWAVES;
    unsigned char* ws = args.ws;
    const float* x_in = args.in[0];
    bf16* XB = (bf16*)(ws + WS_XB);
    bf16* SEGB = (bf16*)(ws + WS_A);
    bf16* QS = SEGB; bf16* VI = SEGB + 1 * (SEG_BYTES / 2); bf16* GT = SEGB + 2 * (SEG_BYTES / 2);
    bf16* AQ = SEGB + 3 * (SEG_BYTES / 2); bf16* AK = SEGB + 4 * (SEG_BYTES / 2); bf16* AV = SEGB + 5 * (SEG_BYTES / 2);
    float* LF = (float*)(ws + WS_LF);
    float* Y = (float*)(ws + WS_A);
    bf16* H = (bf16*)(ws + WS_A);
    bf16* O = (bf16*)(ws + WS_B);
    float* ORAW = (float*)(ws + WS_ORAW);
    float* Y2 = (float*)(ws + WS_B);
    float* out = args.out;

    {
        LAS float* scr = (LAS float*)(L + wave * 16384);
        for (int l = 0; l < DEPTH; ++l) {
            bf16* wl = (bf16*)(ws + WS_W + l * W_LAYER);
            constexpr int I_IN = (D / 64) * (NIN / 32), I_O = (D / 64) * (D / 32), I_1 = (D / 64) * (FF / 32), I_2 = (FF / 64) * (D / 32);
            for (int it = gw; it < I_IN + I_O + I_1 + I_2; it += NGW) {
                int r = it;
                if (r < I_IN) { p0_transpose_item(args.in[1] + (size_t)l * D * NIN, D, NIN, wl + W_IN / 2, scr, r, lane); continue; } r -= I_IN;
                if (r < I_O) { p0_transpose_item(args.in[2] + (size_t)l * D * D, D, D, wl + W_O / 2, scr, r, lane); continue; } r -= I_O;
                if (r < I_1) { p0_transpose_item(args.in[7] + (size_t)l * D * FF, D, FF, wl + W_1 / 2, scr, r, lane); continue; } r -= I_1;
                p0_transpose_item(args.in[8] + (size_t)l * FF * D, FF, D, wl + W_2 / 2, scr, r, lane);
            }
        }
        for (size_t i = (size_t)blockIdx.x * 512 + tid; i < (size_t)M * D / 4; i += (size_t)G * 512) {
            const f32x4 v = ((const f32x4*)x_in)[i]; v2u w; w.x = pk2(v.x, v.y); w.y = pk2(v.z, v.w); ((v2u*)XB)[i] = w; }
    }
    grid.sync();

    for (int l = 0; l < DEPTH; ++l) {
        const bf16* wl = (const bf16*)(ws + WS_W + l * W_LAYER);
        const float* res0 = l == 0 ? x_in : out;
        {
            pg8::Gemm g{XB, wl + W_IN / 2, M, NIN, D}; pg8::StaticOrder S; { int bx = blockIdx.x, Gs = G; asm volatile("" : "+s"(bx), "+s"(Gs)); S.init(M, NIN, Gs, bx); }
            pg8::EpiInProj E{SEGB, LF, args.in[3], args.in[3] + HW, l};
            pg8::gemm_phase<pg8::EpiInProj, pg8::StaticOrder, true, true>(L, g, S, E);
        }
        grid.sync();
        hgrn_simple(QS, LF, VI, ORAW, gw, lane);
        attn_mfma(AQ, AK, AV, O, XB, (float*)(ws + WS_ML), L, tid);
        grid.sync();
        hgrn_finalize(ORAW, GT, args.in[4] + l * HW, O, gw, NGW, lane);
        attn_merge(O, XB, (const float*)(ws + WS_ML), gw, NGW, lane);
        grid.sync();
        {
            pg8::Gemm g{O, wl + W_O / 2, M, D, D}; pg8::StaticOrder S; { int bx = blockIdx.x, Gs = G; asm volatile("" : "+s"(bx), "+s"(Gs)); S.init(M, D, Gs, bx); }
            pg8::EpiResid E{res0, Y, ALPHA};
            pg8::gemm_phase<pg8::EpiResid, pg8::StaticOrder, true, true>(L, g, S, E);
        }
        grid.sync();
        ln_rows(Y, out, XB, args.in[5] + l * D, args.in[6] + l * D, gw, NGW, lane);
        grid.sync();
        {
            pg8::Gemm g{XB, wl + W_1 / 2, M, FF, D}; pg8::StaticOrder S; { int bx = blockIdx.x, Gs = G; asm volatile("" : "+s"(bx), "+s"(Gs)); S.init(M, FF, Gs, bx); }
            pg8::EpiSqRelu E{H};
            pg8::gemm_phase<pg8::EpiSqRelu, pg8::StaticOrder, true, true>(L, g, S, E);
        }
        grid.sync();
        {
            pg8::Gemm g{H, wl + W_2 / 2, M, D, FF}; pg8::StaticOrder S; { int bx = blockIdx.x, Gs = G; asm volatile("" : "+s"(bx), "+s"(Gs)); S.init(M, D, Gs, bx); }
            pg8::EpiResid E{out, Y2, ALPHA};
            pg8::gemm_phase<pg8::EpiResid, pg8::StaticOrder, true, true>(L, g, S, E);
        }
        grid.sync();
        ln_rows(Y2, out, XB, args.in[9] + l * D, args.in[10] + l * D, gw, NGW, lane);
        if (l + 1 < DEPTH) grid.sync();
    }
}

extern "C" void kernel_launch(void* const* d_in, const int* in_sizes, int n_in, void* d_out, int out_size, void* d_ws, size_t ws_size, hipStream_t stream) {
    static int grid = 0;
    if (grid == 0) {
        if (n_in != 11 || in_sizes[0] != M * D || out_size != M * D || ws_size < WS_END) { fprintf(stderr, "kernel_launch: unexpected shapes / workspace (%d inputs, ws %zu)\n", n_in, ws_size); grid = -1; return; }
        int dev = 0, cus = 0, per_cu = 0;
        hipGetDevice(&dev); hipDeviceGetAttribute(&cus, hipDeviceAttributeMultiprocessorCount, dev);
        hipFuncSetAttribute((const void*)fwd_mega, hipFuncAttributeMaxDynamicSharedMemorySize, LDS_BYTES);
        hipOccupancyMaxActiveBlocksPerMultiprocessor(&per_cu, (const void*)fwd_mega, 512, LDS_BYTES);
        if (per_cu < 1) per_cu = 1;
        grid = cus;
        (void)hipGetLastError();
    }
    if (grid < 0) return;
    Args a{};
    for (int i = 0; i < 11; ++i) a.in[i] = (const float*)d_in[i];
    a.out = (float*)d_out; a.ws = (unsigned char*)d_ws;
    void* kargs[] = {&a};
    hipError_t e = hipLaunchCooperativeKernel((const void*)fwd_mega, dim3(grid), dim3(512), kargs, LDS_BYTES, stream);
    if (e != hipSuccess) fprintf(stderr, "cooperative launch failed: %s (grid %d)\n", hipGetErrorString(e), grid);
}
```

```cpp
#include <hip/hip_runtime.h>
#include <cstdio>
#include <cstdint>
namespace pg8 {
#define PG8_LAS __attribute__((address_space(3)))
typedef unsigned short bf16_t;
typedef short bf16x8 __attribute__((ext_vector_type(8)));
typedef float f32x4 __attribute__((ext_vector_type(4)));
typedef unsigned u32x4 __attribute__((ext_vector_type(4)));
constexpr int BM = 256, BK = 64, HALF = 128, HTB = HALF * BK * 2  , STAGE_BYTES = 8 * HTB, NXCD = 8, WGM = 8;

__host__ __device__ __forceinline__ int lds_byte(int r, int c) { const int st = (r >> 4) * 2 + (c >> 5), rr = r & 15, cc = c & 31, ob = rr * 64 + cc * 2; return st * 1024 + (ob ^ (((ob >> 9) & 1) << 5)); }
__host__ __device__ __forceinline__ void stage_rc(int b, int& R, int& C) { const int st = b / 1024, sb = b % 1024, swz = sb ^ (((sb >> 9) & 1) << 5); R = (st >> 1) * 16 + swz / 64; C = (st & 1) * 32 + (swz % 64) / 2; }
__host__ __device__ __forceinline__ int perm32(int rho) { const int n = rho >> 4, i = rho & 15; return 8 * (i >> 2) + 4 * n + (i & 3); }

struct Unit { int pm, pn; };
struct Gemm { const bf16_t* A; const bf16_t* Bt; int M, N, K; };

struct StaticOrder {
    int nM, nN, nwg, G, c;
    __host__ __device__ void init(int M, int N, int G_, int c_) { nM = M / BM; nN = N / BM; nwg = nM * nN; G = G_; c = c_; }
    __host__ __device__ bool next(int i, Unit& u) const {
        const long L = (long)i * G + c; if (L >= nwg) return false;
        int wgid = (int)L; { const int q = nwg / NXCD, r = nwg % NXCD, xcd = wgid % NXCD, off = wgid / NXCD; wgid = (xcd < r ? xcd * (q + 1) : r * (q + 1) + (xcd - r) * q) + off; }
        const int nig = WGM * nN, gid = wgid / nig, fm = gid * WGM, gsz = (nM - fm) < WGM ? (nM - fm) : WGM;
        u.pm = fm + ((wgid % nig) % gsz); u.pn = (wgid % nig) / gsz; return true;
    }
    __device__ __forceinline__ void a_ready(const Unit&) const {}
    __device__ __forceinline__ void done(const Unit&) const {}
};

__device__ __forceinline__ unsigned cvt_pk_bf16(float lo, float hi) { unsigned r; asm volatile("v_cvt_pk_bf16_f32 %0, %1, %2" : "=v"(r) : "v"(lo), "v"(hi)); return r; }
typedef float f32x2 __attribute__((ext_vector_type(2)));
__device__ __forceinline__ f32x2 gelu_pk(f32x2 v) {
    const f32x2 av = __builtin_elementwise_abs(v), d = av * 0.2316418882f + 1.0f;
    f32x2 t; t.x = __builtin_amdgcn_rcpf(d.x); t.y = __builtin_amdgcn_rcpf(d.y);
    f32x2 q = t * 0.5307027145f + (-0.7265760135f); q = q * t + 0.7107068705f; q = q * t + (-0.142248368f); q = q * t + 0.127414796f; q = q * t;
    const f32x2 s = (v * v) * (-0.72134752044f);
    f32x2 e; e.x = __builtin_amdgcn_exp2f(s.x); e.y = __builtin_amdgcn_exp2f(s.y);
    const f32x2 m = v * (q * e), r = v - m;
    f32x2 o; o.x = v.x < 0.f ? m.x : r.x; o.y = v.y < 0.f ? m.y : r.y; return o;
}

template <int ACT  > struct EpiBf16 {
    static constexpr bool PERM = true, AFTER_DRAIN = false; static_assert(ACT == 0 || ACT == 1, "EpiBf16: ACT is 0 (none) or 1 (gelu_pk)");
    bf16_t* O; int ldc; const float* bias; int split_cols; size_t split_stride; float scale0;
    __device__ __forceinline__ void operator()(const f32x4 (&acc)[2][2][4][2], const Unit& u, int wr, int wc, int fr, int fq) const {
        const int row0 = u.pm * BM + wr * 64 + fr; int colt = u.pn * BM; bf16_t* base = O;
        float sc = 1.f; if (split_cols) { const int t = colt / split_cols; base += (size_t)t * split_stride; colt -= t * split_cols; if (t == 0) sc = scale0; }
        const int col0 = colt + wc * 32 + 8 * fq, bcol0 = u.pn * BM + wc * 32 + 8 * fq;
        f32x4 bv[2][2];
#pragma unroll
        for (int bj = 0; bj < 2; ++bj)
#pragma unroll
            for (int n = 0; n < 2; ++n) bv[bj][n] = bias ? *(const f32x4*)(bias + bcol0 + bj * HALF + 4 * n) : (f32x4){0.f, 0.f, 0.f, 0.f};
#pragma unroll
        for (int ai = 0; ai < 2; ++ai)
#pragma unroll
            for (int m = 0; m < 4; ++m) { bf16_t* rowp = base + (size_t)(row0 + ai * HALF + m * 16) * ldc + col0;
#pragma unroll
                for (int bj = 0; bj < 2; ++bj) { f32x4 v0 = acc[ai][bj][m][0] + bv[bj][0], v1 = acc[ai][bj][m][1] + bv[bj][1];
                    if (ACT == 1) { f32x2 a = gelu_pk((f32x2){v0[0], v0[1]}), b = gelu_pk((f32x2){v0[2], v0[3]}), c = gelu_pk((f32x2){v1[0], v1[1]}), d = gelu_pk((f32x2){v1[2], v1[3]});
                        v0 = (f32x4){a.x, a.y, b.x, b.y}; v1 = (f32x4){c.x, c.y, d.x, d.y}; }
                    v0 = v0 * sc; v1 = v1 * sc; u32x4 w; w.x = cvt_pk_bf16(v0[0], v0[1]); w.y = cvt_pk_bf16(v0[2], v0[3]); w.z = cvt_pk_bf16(v1[0], v1[1]); w.w = cvt_pk_bf16(v1[2], v1[3]);
                    *(u32x4*)(rowp + bj * HALF) = w; } }
    }
};

struct PanelStats {
    unsigned* xbuf;
    unsigned* cnt;
    unsigned* tmo;
    int ntn; float eps;
    unsigned code;
    __device__ __forceinline__ bool run(const f32x4 (&v)[2][2][4][2], const Unit& u, int wr, int wc, int fr, int fq, PG8_LAS unsigned char* lds, int wid, int lane) const {
        typedef float f32x2v __attribute__((ext_vector_type(2)));
        PG8_LAS f32x2v* P = (PG8_LAS f32x2v*)lds;
        PG8_LAS f32x2v* S = (PG8_LAS f32x2v*)(lds + 8192);
        PG8_LAS unsigned* flag = (PG8_LAS unsigned*)(lds + 8192 + 2048);
#pragma unroll
        for (int ai = 0; ai < 2; ++ai)
#pragma unroll
            for (int m = 0; m < 4; ++m) {
                float s = 0.f;
#pragma unroll
                for (int bj = 0; bj < 2; ++bj)
#pragma unroll
                    for (int n = 0; n < 2; ++n) { const f32x4 x = v[ai][bj][m][n]; s += (x[0] + x[1]) + (x[2] + x[3]); }
                s += __shfl_xor(s, 16); s += __shfl_xor(s, 32);
                const float mw = s * (1.0f / 64.0f); float q = 0.f;
#pragma unroll
                for (int bj = 0; bj < 2; ++bj)
#pragma unroll
                    for (int n = 0; n < 2; ++n) { const f32x4 d = v[ai][bj][m][n] - mw; q += (d[0] * d[0] + d[1] * d[1]) + (d[2] * d[2] + d[3] * d[3]); }
                q += __shfl_xor(q, 16); q += __shfl_xor(q, 32);
                if (fq == 0) P[(ai * HALF + wr * 64 + m * 16 + fr) * 4 + wc] = (f32x2v){mw, q};
            }
        asm volatile("s_waitcnt lgkmcnt(0)" ::: "memory"); __builtin_amdgcn_s_barrier(); asm volatile("" ::: "memory");
#if defined(BROKEN_EXCHANGE_NO_WAIT)
#warning BROKEN CONTROL BUILD: the row-statistics exchange does not wait; results are wrong by design
        if (blockIdx.x >= 64) { const long long t0_ = clock64(); while (clock64() - t0_ < 60000) __builtin_amdgcn_s_sleep(8); }
#endif
        const int row = wid * 32 + (lane & 31);
        if (lane < 32) {
            const f32x2v a = P[row * 4 + 0], b = P[row * 4 + 1], c = P[row * 4 + 2], d = P[row * 4 + 3];
            const float mt = (a.x + b.x + c.x + d.x) * 0.25f;
            const float da = a.x - mt, db = b.x - mt, dc = c.x - mt, dd = d.x - mt;
            const float m2 = (a.y + b.y) + (c.y + d.y) + 64.0f * ((da * da + db * db) + (dc * dc + dd * dd));
            unsigned long long* slot = (unsigned long long*)xbuf + ((size_t)(u.pm * BM + row) * 4 + u.pn);
            __hip_atomic_store(slot, ((unsigned long long)__float_as_uint(m2) << 32) | __float_as_uint(mt), __ATOMIC_RELAXED, __HIP_MEMORY_SCOPE_AGENT);
        }
        asm volatile("s_waitcnt vmcnt(0)" ::: "memory");
        if (lane == 0) __hip_atomic_fetch_add(cnt + 64 * u.pm, 1u, __ATOMIC_RELAXED, __HIP_MEMORY_SCOPE_AGENT);
        if (wid == 0) {
            bool dead = false; const unsigned long long t0 = __builtin_amdgcn_s_memrealtime(); const unsigned want = 8u * (unsigned)ntn;
            for (;;) {
#if defined(BROKEN_EXCHANGE_NO_WAIT)
                break;
#endif
                if ((unsigned)__builtin_amdgcn_readfirstlane(__hip_atomic_load(cnt + 64 * u.pm, __ATOMIC_RELAXED, __HIP_MEMORY_SCOPE_AGENT)) >= want) break;
                if (__builtin_amdgcn_s_memrealtime() - t0 > 2000000ull) {
                    if (lane == 0) { unsigned expect = 0u; __hip_atomic_compare_exchange_strong(tmo + 1, &expect, code | (unsigned)(u.pm & 0xff), __ATOMIC_RELAXED, __ATOMIC_RELAXED, __HIP_MEMORY_SCOPE_AGENT);
                                     __hip_atomic_store(tmo, 1u, __ATOMIC_RELAXED, __HIP_MEMORY_SCOPE_AGENT); }
                    dead = true; break; }
                __builtin_amdgcn_s_sleep(2);
            }
            __builtin_amdgcn_fence(__ATOMIC_ACQUIRE, "agent");
            if (lane == 0) flag[0] = dead ? 1u : 0u;
        }
        asm volatile("s_waitcnt vmcnt(0) lgkmcnt(0)" ::: "memory"); __builtin_amdgcn_s_barrier(); asm volatile("" ::: "memory");
        const bool bad = flag[0] != 0u;
        if (lane < 32) {
            const unsigned long long* slot = (const unsigned long long*)xbuf + (size_t)(u.pm * BM + row) * 4; float mt[4], m2[4]; float ms = 0.f;
#pragma unroll
            for (int t = 0; t < 4; ++t) { if (t < ntn) { const unsigned long long w = __hip_atomic_load(slot + t, __ATOMIC_RELAXED, __HIP_MEMORY_SCOPE_AGENT); mt[t] = __uint_as_float((unsigned)w); m2[t] = __uint_as_float((unsigned)(w >> 32)); } else { mt[t] = 0.f; m2[t] = 0.f; } ms += mt[t]; }
            const float mean = ms / (float)ntn; float q = 0.f;
#pragma unroll
            for (int t = 0; t < 4; ++t) if (t < ntn) { const float dm = mt[t] - mean; q += m2[t] + 256.0f * dm * dm; }
            S[row] = (f32x2v){mean, 1.0f / sqrtf(q / (256.0f * (float)ntn) + eps)};
        }
        asm volatile("s_waitcnt lgkmcnt(0)" ::: "memory"); __builtin_amdgcn_s_barrier(); asm volatile("" ::: "memory");
        return bad;
    }
};
struct EpiLnRes {
    static constexpr bool PERM = false, AFTER_DRAIN = true;
    const float* base; float* out; int ldc; const float* bias; PanelStats st; unsigned poison;
    __device__ __forceinline__ void fused(f32x4 (&acc)[2][2][4][2], const Unit& u, int wr, int wc, int fr, int fq, PG8_LAS unsigned char* lds, int wid, int lane) const {
        typedef float f32x2v __attribute__((ext_vector_type(2)));
        const PG8_LAS f32x2v* S = (const PG8_LAS f32x2v*)(lds + 8192);
        const int col0 = u.pn * BM + wc * 32 + 4 * fq;
#pragma unroll
        for (int bj = 0; bj < 2; ++bj)
#pragma unroll
            for (int n = 0; n < 2; ++n) { const f32x4 bv = bias ? *(const f32x4*)(bias + col0 + bj * HALF + n * 16) : (f32x4){0.f, 0.f, 0.f, 0.f};
#pragma unroll
                for (int ai = 0; ai < 2; ++ai)
#pragma unroll
                    for (int m = 0; m < 4; ++m) acc[ai][bj][m][n] += bv; }
        f32x4 pre[4][2][2];
#pragma unroll
        for (int m = 0; m < 4; ++m) { const size_t off = (size_t)(u.pm * BM + wr * 64 + m * 16 + fr) * ldc + col0;
#pragma unroll
            for (int bj = 0; bj < 2; ++bj)
#pragma unroll
                for (int n = 0; n < 2; ++n) pre[m][bj][n] = *(const f32x4*)(base + off + bj * HALF + n * 16); }
        const bool bad = st.run(acc, u, wr, wc, fr, fq, lds, wid, lane) || poison != 0u;
        const float qnan = __builtin_nanf("");
#pragma unroll
        for (int ai = 0; ai < 2; ++ai)
#pragma unroll
            for (int m = 0; m < 4; ++m) { const int r = ai * HALF + wr * 64 + m * 16 + fr; const f32x2v sr = S[r]; const size_t off = (size_t)(u.pm * BM + r) * ldc + col0;
#pragma unroll
                for (int bj = 0; bj < 2; ++bj)
#pragma unroll
                    for (int n = 0; n < 2; ++n) { const f32x4 bs = ai == 0 ? pre[m][bj][n] : *(const f32x4*)(base + off + bj * HALF + n * 16); f32x4 o = bs + (acc[ai][bj][m][n] - sr.x) * sr.y;
                        if (bad) o = (f32x4){qnan, qnan, qnan, qnan}; *(f32x4*)(out + off + bj * HALF + n * 16) = o; }
                if (m & 1) asm volatile("" ::: "memory"); }
    }
};
struct EpiLnResLn {
    static constexpr bool PERM = false, AFTER_DRAIN = true;
    const float* base; float* out; bf16_t* xn; int ldc; const float* bias; PanelStats st1, st2; unsigned poison;
    __device__ __forceinline__ void fused(f32x4 (&acc)[2][2][4][2], const Unit& u, int wr, int wc, int fr, int fq, PG8_LAS unsigned char* lds, int wid, int lane) const {
        typedef float f32x2v __attribute__((ext_vector_type(2))); typedef unsigned u32x2v __attribute__((ext_vector_type(2)));
        const PG8_LAS f32x2v* S = (const PG8_LAS f32x2v*)(lds + 8192);
        const int col0 = u.pn * BM + wc * 32 + 4 * fq;
#pragma unroll
        for (int bj = 0; bj < 2; ++bj)
#pragma unroll
            for (int n = 0; n < 2; ++n) { const f32x4 bv = bias ? *(const f32x4*)(bias + col0 + bj * HALF + n * 16) : (f32x4){0.f, 0.f, 0.f, 0.f};
#pragma unroll
                for (int ai = 0; ai < 2; ++ai)
#pragma unroll
                    for (int m = 0; m < 4; ++m) acc[ai][bj][m][n] += bv; }
        bool bad = st1.run(acc, u, wr, wc, fr, fq, lds, wid, lane) || poison != 0u;
        const float qnan = __builtin_nanf("");
#pragma unroll
        for (int ai = 0; ai < 2; ++ai)
#pragma unroll
            for (int m = 0; m < 4; ++m) { const int r = ai * HALF + wr * 64 + m * 16 + fr; const f32x2v sr = S[r]; const size_t off = (size_t)(u.pm * BM + r) * ldc + col0;
#pragma unroll
                for (int bj = 0; bj < 2; ++bj)
#pragma unroll
                    for (int n = 0; n < 2; ++n) { const f32x4 bs = *(const f32x4*)(base + off + bj * HALF + n * 16); acc[ai][bj][m][n] = bs + (acc[ai][bj][m][n] - sr.x) * sr.y; }
                asm volatile("" : "+v"(acc[ai][0][m][0]), "+v"(acc[ai][0][m][1]), "+v"(acc[ai][1][m][0]), "+v"(acc[ai][1][m][1]));
                if (m & 1) asm volatile("" ::: "memory"); }
        const bool bad1 = bad;
        bad = st2.run(acc, u, wr, wc, fr, fq, lds, wid, lane) || bad;
#pragma unroll
        for (int ai = 0; ai < 2; ++ai)
#pragma unroll
            for (int m = 0; m < 4; ++m) { const int r = ai * HALF + wr * 64 + m * 16 + fr; const f32x2v sr = S[r]; const size_t off = (size_t)(u.pm * BM + r) * ldc + col0;
#pragma unroll
                for (int bj = 0; bj < 2; ++bj)
#pragma unroll
                    for (int n = 0; n < 2; ++n) { const f32x4 x1 = acc[ai][bj][m][n]; *(f32x4*)(out + off + bj * HALF + n * 16) = bad1 ? (f32x4){qnan, qnan, qnan, qnan} : x1;
                        const f32x4 o = (x1 - sr.x) * sr.y; u32x2v w; w.x = cvt_pk_bf16(o[0], o[1]); w.y = cvt_pk_bf16(o[2], o[3]);
                        if (bad) { w.x = 0x7fc07fc0u; w.y = 0x7fc07fc0u; } *(u32x2v*)(xn + off + bj * HALF + n * 16) = w; }
                asm volatile("" ::: "memory"); }
    }
};

template <class Epi, class Sched, bool ALIGN_EPI = false, bool SP2 = false>
__device__ __forceinline__ void gemm_phase(PG8_LAS unsigned char* lds, const Gemm g, const Sched& S, const Epi& E) {
    int tid_ = threadIdx.x; asm volatile("" : "+v"(tid_));
    const int tid = tid_, wid = __builtin_amdgcn_readfirstlane(tid >> 6), lane = tid & 63, wr = wid >> 2, wc = wid & 3, fr = lane & 15, fq = lane >> 4;
    const int K = g.K, nt = K / BK;
    unsigned voffA[2], voffB[2];
#pragma unroll
    for (int i = 0; i < 2; ++i) { int R, C; stage_rc(tid * 16 + i * 8192, R, C); const int Rb = Epi::PERM ? ((R & ~31) + perm32(R & 31)) : R;
        voffA[i] = (unsigned)(R * K + C) * 2u; voffB[i] = (unsigned)(Rb * K + C) * 2u; }
    const size_t kstep = (size_t)(BK * 2);
    const size_t hstep = (size_t)HALF * K * 2;
    const size_t tstep = 2 * hstep;
    const unsigned ldsw = (unsigned)wid * 1024u;
    const int aoff = lds_byte(wr * 64 + fr, fq * 8), boff = lds_byte(wc * 32 + fr, fq * 8);
#define PG8_SA(b, h) (((b) * 2 + (h)) * HTB)
#define PG8_SB(b, h) ((4 + (b) * 2 + (h)) * HTB)
#define PG8_STAGE(bufoff, gbase, voff) do { _Pragma("unroll") for (int _i = 0; _i < 2; ++_i) \
        __builtin_amdgcn_global_load_lds((const unsigned*)((const char*)(gbase) + (voff)[_i]), (PG8_LAS unsigned*)(lds + (bufoff) + ldsw + _i * 8192), 16, 0, 0); } while (0)
#define PG8_LDA(dst, b, h) do { _Pragma("unroll") for (int m = 0; m < 4; ++m) _Pragma("unroll") for (int k = 0; k < 2; ++k) dst[m][k] = *(const PG8_LAS bf16x8*)(lds + PG8_SA(b, h) + aoff + m * 2048 + k * 1024); } while (0)
#define PG8_LDB(dst, b, h) do { _Pragma("unroll") for (int n = 0; n < 2; ++n) _Pragma("unroll") for (int k = 0; k < 2; ++k) dst[n][k] = *(const PG8_LAS bf16x8*)(lds + PG8_SB(b, h) + boff + n * 2048 + k * 1024); } while (0)
#define PG8_MMA(ai, bj, At, Bt) do { __builtin_amdgcn_s_setprio(1); _Pragma("unroll") for (int m = 0; m < 4; ++m) _Pragma("unroll") for (int n = 0; n < 2; ++n) _Pragma("unroll") for (int k = 0; k < 2; ++k) \
        acc[ai][bj][m][n] = __builtin_amdgcn_mfma_f32_16x16x32_bf16(Bt[n][k], At[m][k], acc[ai][bj][m][n], 0, 0, 0); __builtin_amdgcn_s_setprio(0); } while (0)
#define PG8_WAIT_V(n) asm volatile("s_waitcnt vmcnt(" #n ")" ::: "memory")
#define PG8_WAIT_L(n) asm volatile("s_waitcnt lgkmcnt(" #n ")" ::: "memory")
#define PG8_BAR __builtin_amdgcn_s_barrier()
#define PG8_SCHED __builtin_amdgcn_sched_barrier(0)
    Unit cur, nxt; int ui = 0;
    if (!S.next(0, cur)) return;
    f32x4 acc[2][2][4][2];
#pragma unroll
    for (int a = 0; a < 2; ++a)
#pragma unroll
        for (int b = 0; b < 2; ++b)
#pragma unroll
            for (int m = 0; m < 4; ++m)
#pragma unroll
                for (int n = 0; n < 2; ++n) acc[a][b][m][n] = (f32x4){0.f, 0.f, 0.f, 0.f};
    bf16x8 At[4][2], B0[2][2], B1[2][2];
    const char* cA = (const char*)g.A + (size_t)cur.pm * tstep; const char* cB = (const char*)g.Bt + (size_t)cur.pn * tstep;
    S.a_ready(cur);
    if constexpr (SP2) {
        PG8_STAGE(PG8_SB(0, 0), cB, voffB); PG8_STAGE(PG8_SB(0, 1), cB + hstep, voffB); PG8_STAGE(PG8_SA(0, 0), cA, voffA); PG8_STAGE(PG8_SA(0, 1), cA + hstep, voffA);
        if (wr == 1) PG8_BAR;
        PG8_WAIT_V(2); PG8_BAR;
        PG8_STAGE(PG8_SB(1, 0), cB + kstep, voffB); PG8_STAGE(PG8_SA(1, 0), cA + kstep, voffA); PG8_STAGE(PG8_SB(1, 1), cB + hstep + kstep, voffB);
        PG8_WAIT_V(6); PG8_BAR;
    } else {
        PG8_STAGE(PG8_SB(0, 0), cB, voffB); PG8_STAGE(PG8_SA(0, 0), cA, voffA); PG8_STAGE(PG8_SB(0, 1), cB + hstep, voffB); PG8_STAGE(PG8_SA(0, 1), cA + hstep, voffA);
        if (wr == 1) PG8_BAR;
        PG8_WAIT_V(4); PG8_BAR;
        PG8_STAGE(PG8_SB(1, 0), cB + kstep, voffB); PG8_STAGE(PG8_SA(1, 0), cA + kstep, voffA); PG8_STAGE(PG8_SB(1, 1), cB + hstep + kstep, voffB);
        PG8_WAIT_V(6); PG8_BAR;
    }
    for (;;) {
        const bool has_next = S.next(ui + 1, nxt);
        const char* nA = has_next ? (const char*)g.A + (size_t)nxt.pm * tstep : cA; const char* nB = has_next ? (const char*)g.Bt + (size_t)nxt.pn * tstep : cB;
        for (int t = 0; t < nt; t += 2) {
            const bool last = (t == nt - 2);
            const char* a1 = cA + (size_t)(t + 1) * kstep;
            const char* a2 = last ? nA : cA + (size_t)(t + 2) * kstep; const char* b2 = last ? nB : cB + (size_t)(t + 2) * kstep;
            const char* a3 = a2 + kstep; const char* b3 = b2 + kstep;
            if (last && has_next) S.a_ready(nxt);
            if constexpr (SP2) {
            PG8_LDB(B0, 0, 0); PG8_LDB(B1, 0, 1); PG8_SCHED; PG8_LDA(At, 0, 0); PG8_STAGE(PG8_SA(1, 1), a1 + hstep, voffA);
            PG8_WAIT_V(8); PG8_WAIT_L(0); PG8_BAR; PG8_MMA(0, 0, At, B0); PG8_MMA(0, 1, At, B1); PG8_BAR; PG8_SCHED;
            PG8_LDA(At, 0, 1); PG8_STAGE(PG8_SB(0, 0), b2, voffB); PG8_STAGE(PG8_SB(0, 1), b2 + hstep, voffB); PG8_STAGE(PG8_SA(0, 0), a2, voffA);
            PG8_WAIT_V(8); PG8_WAIT_L(0); PG8_BAR; PG8_MMA(1, 0, At, B0); PG8_MMA(1, 1, At, B1); PG8_BAR; PG8_SCHED;
            PG8_LDB(B0, 1, 0); PG8_LDB(B1, 1, 1); PG8_SCHED; PG8_LDA(At, 1, 0); PG8_STAGE(PG8_SA(0, 1), a2 + hstep, voffA);
            PG8_WAIT_V(8); PG8_WAIT_L(0); PG8_BAR; PG8_MMA(0, 0, At, B0); PG8_MMA(0, 1, At, B1); PG8_BAR; PG8_SCHED;
            PG8_LDA(At, 1, 1); PG8_STAGE(PG8_SB(1, 0), b3, voffB); PG8_STAGE(PG8_SB(1, 1), b3 + hstep, voffB); PG8_STAGE(PG8_SA(1, 0), a3, voffA);
            PG8_WAIT_V(8); PG8_WAIT_L(0); PG8_BAR; PG8_MMA(1, 0, At, B0); PG8_MMA(1, 1, At, B1); PG8_BAR; PG8_SCHED;
            } else {
            PG8_LDB(B0, 0, 0); PG8_SCHED; PG8_LDA(At, 0, 0); PG8_STAGE(PG8_SA(1, 1), a1 + hstep, voffA);
            PG8_WAIT_L(8); PG8_BAR; PG8_WAIT_L(0); PG8_MMA(0, 0, At, B0); PG8_BAR; PG8_SCHED;
            PG8_LDB(B1, 0, 1); PG8_STAGE(PG8_SB(0, 0), b2, voffB);
            PG8_BAR; PG8_WAIT_L(0); PG8_MMA(0, 1, At, B1); PG8_BAR;
            PG8_LDA(At, 0, 1); PG8_STAGE(PG8_SA(0, 0), a2, voffA);
            PG8_BAR; PG8_WAIT_L(0); PG8_MMA(1, 0, At, B0); PG8_BAR; PG8_SCHED;
            PG8_STAGE(PG8_SB(0, 1), b2 + hstep, voffB);
            PG8_WAIT_V(6); PG8_BAR; PG8_MMA(1, 1, At, B1); PG8_BAR;
            PG8_LDB(B0, 1, 0); PG8_SCHED; PG8_LDA(At, 1, 0); PG8_STAGE(PG8_SA(0, 1), a2 + hstep, voffA);
            PG8_WAIT_L(8); PG8_BAR; PG8_WAIT_L(0); PG8_MMA(0, 0, At, B0); PG8_BAR; PG8_SCHED;
            PG8_LDB(B1, 1, 1); PG8_STAGE(PG8_SB(1, 0), b3, voffB);
            PG8_BAR; PG8_WAIT_L(0); PG8_MMA(0, 1, At, B1); PG8_BAR;
            PG8_LDA(At, 1, 1); PG8_STAGE(PG8_SA(1, 0), a3, voffA);
            PG8_BAR; PG8_WAIT_L(0); PG8_MMA(1, 0, At, B0); PG8_BAR; PG8_SCHED;
            PG8_STAGE(PG8_SB(1, 1), b3 + hstep, voffB);
            PG8_WAIT_V(6); PG8_BAR; PG8_MMA(1, 1, At, B1); PG8_BAR;
            }
        }
        if constexpr (ALIGN_EPI) { if (wr == 0) PG8_BAR; }
        if constexpr (!Epi::AFTER_DRAIN) { E(acc, cur, wr, wc, fr, fq); S.done(cur); }
        if (!has_next) break;
#pragma unroll
        for (int a = 0; a < 2; ++a)
#pragma unroll
            for (int b = 0; b < 2; ++b)
#pragma unroll
                for (int m = 0; m < 4; ++m)
#pragma unroll
                    for (int n = 0; n < 2; ++n) acc[a][b][m][n] = (f32x4){0.f, 0.f, 0.f, 0.f};
        cur = nxt; cA = nA; cB = nB; ++ui;
        if constexpr (ALIGN_EPI) { if (wr == 1) PG8_BAR; }
    }
    PG8_WAIT_V(0);
    if constexpr (!ALIGN_EPI) { if (wr == 0) PG8_BAR; }
    PG8_BAR;
    if constexpr (Epi::AFTER_DRAIN) { E.fused(acc, cur, wr, wc, fr, fq, lds, wid, lane); S.done(cur); }
#undef PG8_SA
#undef PG8_SB
#undef PG8_STAGE
#undef PG8_LDA
#undef PG8_LDB
#undef PG8_MMA
#undef PG8_WAIT_V
#undef PG8_WAIT_L
#undef PG8_BAR
#undef PG8_SCHED
}
}

#include <hip/hip_cooperative_groups.h>
namespace cg = cooperative_groups;

#define GAS __attribute__((address_space(1)))
#define LAS __attribute__((address_space(3)))
typedef unsigned short bf16;
typedef unsigned v4u __attribute__((ext_vector_type(4)));
typedef unsigned v2u __attribute__((ext_vector_type(2)));
typedef unsigned u32x4w __attribute__((ext_vector_type(4)));
typedef float f32x4 __attribute__((ext_vector_type(4)));
typedef short bf16x8 __attribute__((ext_vector_type(8)));
#define LDS_WAIT() asm volatile("s_waitcnt lgkmcnt(0)" ::: "memory")

constexpr int BATCH = 2, SEQ = 16384, D = 1024, M = BATCH * SEQ, NIN = 3584, FF = 4096, DEPTH = 2;
constexpr int HW = 512;
constexpr float ALPHA = 1.4142135623730951f;
constexpr float LN_EPS = 1e-5f, RMS_EPS = 1e-6f;
constexpr size_t MiB = 1u << 20;
constexpr size_t WS_W = 0;
constexpr size_t W_LAYER = 25 * MiB, W_IN = 0, W_O = 7 * MiB, W_1 = 9 * MiB, W_2 = 17 * MiB;
constexpr size_t WS_XB = 52 * MiB;
constexpr size_t WS_A = 116 * MiB;
constexpr size_t SEG_BYTES = 32 * MiB;
constexpr size_t WS_LF = WS_A + 6 * SEG_BYTES;
constexpr size_t WS_B = 372 * MiB;
constexpr size_t WS_ORAW = WS_B + 64 * MiB;
constexpr size_t WS_ML = 500 * MiB;
constexpr size_t WS_DV = 506 * MiB;
constexpr size_t WS_END = 507 * MiB;
constexpr int LDS_BYTES = 131072 + 2048;
constexpr int NWAVES = 8;

__device__ __forceinline__ unsigned f2bf(float f) { unsigned u = __builtin_bit_cast(unsigned, f); return (u + 0x7fffu + ((u >> 16) & 1u)) >> 16; }
__device__ __forceinline__ unsigned pk2(float lo, float hi) { return f2bf(lo) | (f2bf(hi) << 16); }
__device__ __forceinline__ float bf2f(unsigned short h) { return __builtin_bit_cast(float, (unsigned)h << 16); }
__device__ __forceinline__ float bflo(unsigned w) { return __builtin_bit_cast(float, w << 16); }
__device__ __forceinline__ float bfhi(unsigned w) { return __builtin_bit_cast(float, w & 0xffff0000u); }
__device__ __forceinline__ float wave_sum(float v) {
#pragma unroll
    for (int o = 1; o < 64; o <<= 1) v += __shfl_xor(v, o);
    return v;
}
__device__ __forceinline__ float wave_max(float v) {
#pragma unroll
    for (int o = 1; o < 64; o <<= 1) v = fmaxf(v, __shfl_xor(v, o));
    return v;
}

namespace pg8 {
struct EpiInProj {
    static constexpr bool PERM = true, AFTER_DRAIN = false;
    bf16_t* seg; float* lf; const float* lb0; const float* lb1; int layer;
    __device__ __forceinline__ void operator()(const f32x4 (&acc)[2][2][4][2], const Unit& u, int wr, int wc, int fr, int fq) const {
        const int t = u.pn >> 1;
        int row0 = u.pm * BM + wr * 64 + fr;
        int cs0 = (u.pn & 1) * 256 + wc * 32 + 8 * fq; asm volatile("" : "+v"(row0), "+v"(cs0));
        if (t == 1) {
#pragma unroll
            for (int bj = 0; bj < 2; ++bj) {
                float lbv[8];
#pragma unroll
                for (int i = 0; i < 8; ++i) { const int c = cs0 + bj * HALF + i; lbv[i] = layer ? 1.0f / (1.0f + __expf(-(lb1[c] - lb0[c]))) : 0.0f; }
#pragma unroll
                for (int ai = 0; ai < 2; ++ai)
#pragma unroll
                    for (int m = 0; m < 4; ++m) {
                        float* p = lf + (size_t)(row0 + ai * HALF + m * 16) * 512 + cs0 + bj * HALF;
                        f32x4 o[2];
#pragma unroll
                        for (int n = 0; n < 2; ++n)
#pragma unroll
                            for (int e = 0; e < 4; ++e) { const float z = acc[ai][bj][m][n][e]; const float sg = 1.0f / (1.0f + __expf(-z)); const float lb = lbv[n * 4 + e]; o[n][e] = __logf(lb + (1.0f - lb) * sg); }
                        *(f32x4*)p = o[0]; *(f32x4*)(p + 4) = o[1]; asm volatile("" ::: "memory");
                    }
            }
        } else {
            const int di = t == 0 ? 0 : t - 1;
            bf16_t* base = seg + (size_t)di * ((size_t)32 * 1024 * 1024 / 2);
#pragma unroll
            for (int ai = 0; ai < 2; ++ai)
#pragma unroll
                for (int m = 0; m < 4; ++m)
#pragma unroll
                    for (int bj = 0; bj < 2; ++bj) {
                        float v[8];
#pragma unroll
                        for (int n = 0; n < 2; ++n)
#pragma unroll
                            for (int e = 0; e < 4; ++e) { float z = acc[ai][bj][m][n][e];
                                if (t == 0) z = z / (1.0f + __expf(-z));
                                else if (t == 3) z = 1.0f / (1.0f + __expf(-z));
                                else if (t == 4) z = z * 0.18033688011112042f;
                                v[n * 4 + e] = z; }
                        u32x4 w; w.x = cvt_pk_bf16(v[0], v[1]); w.y = cvt_pk_bf16(v[2], v[3]); w.z = cvt_pk_bf16(v[4], v[5]); w.w = cvt_pk_bf16(v[6], v[7]);
                        *(u32x4*)(base + (size_t)(row0 + ai * HALF + m * 16) * 512 + cs0 + bj * HALF) = w;
                    }
        }
    }
};
struct EpiResid {
    static constexpr bool PERM = true, AFTER_DRAIN = false;
    const float* res; float* out; float alpha;
    __device__ __forceinline__ void operator()(const f32x4 (&acc)[2][2][4][2], const Unit& u, int wr, int wc, int fr, int fq) const {
        int row0 = u.pm * BM + wr * 64 + fr; int col0 = u.pn * BM + wc * 32 + 8 * fq; asm volatile("" : "+v"(row0), "+v"(col0));
#pragma unroll
        for (int ai = 0; ai < 2; ++ai)
#pragma unroll
            for (int m = 0; m < 4; ++m)
#pragma unroll
                for (int bj = 0; bj < 2; ++bj) {
                    const size_t off = (size_t)(row0 + ai * HALF + m * 16) * 1024 + col0 + bj * HALF;
                    const f32x4 r0 = *(const f32x4*)(res + off), r1 = *(const f32x4*)(res + off + 4);
                    *(f32x4*)(out + off) = r0 * alpha + acc[ai][bj][m][0]; *(f32x4*)(out + off + 4) = r1 * alpha + acc[ai][bj][m][1];
                    if (bj == 1) asm volatile("" ::: "memory");
                }
    }
};
struct EpiSqRelu {
    static constexpr bool PERM = true, AFTER_DRAIN = false;
    bf16_t* out;
    __device__ __forceinline__ void operator()(const f32x4 (&acc)[2][2][4][2], const Unit& u, int wr, int wc, int fr, int fq) const {
        int row0 = u.pm * BM + wr * 64 + fr; int col0 = u.pn * BM + wc * 32 + 8 * fq; asm volatile("" : "+v"(row0), "+v"(col0));
#pragma unroll
        for (int ai = 0; ai < 2; ++ai)
#pragma unroll
            for (int m = 0; m < 4; ++m)
#pragma unroll
                for (int bj = 0; bj < 2; ++bj) {
                    f32x4 a = acc[ai][bj][m][0], b = acc[ai][bj][m][1];
#pragma unroll
                    for (int e = 0; e < 4; ++e) { a[e] = fmaxf(a[e], 0.f); a[e] *= a[e]; b[e] = fmaxf(b[e], 0.f); b[e] *= b[e]; }
                    u32x4 w; w.x = cvt_pk_bf16(a[0], a[1]); w.y = cvt_pk_bf16(a[2], a[3]); w.z = cvt_pk_bf16(b[0], b[1]); w.w = cvt_pk_bf16(b[2], b[3]);
                    *(u32x4*)(out + (size_t)(row0 + ai * HALF + m * 16) * 4096 + col0 + bj * HALF) = w;
                }
    }
};
}

__device__ __forceinline__ void p0_transpose_item(const float* W, int K, int N, bf16* WT, LAS float* scr, int item, int lane) {
    asm volatile("" : "+v"(lane));
    const int nblk = N / 32, kb = item / nblk, nb = item % nblk, k0 = 64 * kb, n0 = 32 * nb;
#pragma unroll 8
    for (int i = 0; i < 32; ++i) { const int kk = 2 * i + (lane >> 5); scr[kk * 33 + (lane & 31)] = W[(size_t)(k0 + kk) * N + n0 + (lane & 31)]; }
    LDS_WAIT(); asm volatile("" ::: "memory");
    const int c = lane & 7;
#pragma unroll
    for (int j = 0; j < 4; ++j) { const int n = (lane >> 3) + 8 * j; const LAS float* s = scr + (8 * c) * 33 + n;
        v4u o; o.x = pk2(s[0 * 33], s[1 * 33]); o.y = pk2(s[2 * 33], s[3 * 33]); o.z = pk2(s[4 * 33], s[5 * 33]); o.w = pk2(s[6 * 33], s[7 * 33]);
        *(GAS v4u*)(WT + (size_t)(n0 + n) * K + k0 + 8 * c) = o; }
    LDS_WAIT(); asm volatile("" ::: "memory");
}

struct Args { const float* in[11]; float* out; unsigned char* ws; };

__device__ __forceinline__ void ln_rows(const float* src, float* dst, bf16* xb, const float* g, const float* b, int gw, int NGW, int lane) {
    asm volatile("" : "+v"(lane));
    f32x4 gv[4], bv[4];
#pragma unroll
    for (int j = 0; j < 4; ++j) { gv[j] = *((const f32x4*)g + lane + 64 * j); bv[j] = *((const f32x4*)b + lane + 64 * j); }
    for (int m = gw; m < M; m += NGW) {
        const f32x4* xr = (const f32x4*)(src + (size_t)m * D) + lane;
        f32x4 v[4]; float s = 0.f;
#pragma unroll
        for (int j = 0; j < 4; ++j) { v[j] = xr[64 * j]; s += (v[j].x + v[j].y) + (v[j].z + v[j].w); }
        const float mean = wave_sum(s) * (1.f / D); float s2 = 0.f;
#pragma unroll
        for (int j = 0; j < 4; ++j) { v[j] = v[j] - mean; s2 += (v[j].x * v[j].x + v[j].y * v[j].y) + (v[j].z * v[j].z + v[j].w * v[j].w); }
        const float rstd = 1.f / sqrtf(wave_sum(s2) * (1.f / D) + LN_EPS);
        f32x4* o4 = (f32x4*)(dst + (size_t)m * D) + lane;
        v2u* o8 = (v2u*)(xb + (size_t)m * D) + lane;
#pragma unroll
        for (int j = 0; j < 4; ++j) { const f32x4 y = v[j] * rstd * gv[j] + bv[j]; o4[64 * j] = y; v2u w; w.x = pk2(y.x, y.y); w.y = pk2(y.z, y.w); o8[64 * j] = w; }
    }
}

__device__ __forceinline__ void hgrn_simple(const bf16* QS, const float* LF, const bf16* VI, float* ORAW, int gw, int lane) {
    asm volatile("" : "+v"(lane));
    if (gw >= BATCH * 4 * 128) return;
    const int b = gw >> 9, h = (gw >> 7) & 3, v = gw & 127;
    float S0 = 0.f, S1 = 0.f;
    const size_t rb = (size_t)b * SEQ;
    for (int t0 = 0; t0 < SEQ; t0 += 16) {
        float lf0[16], lf1[16], q0[16], q1[16], vv[16];
#pragma unroll
        for (int i = 0; i < 16; ++i) { const size_t o = (rb + t0 + i) * 512 + h * 128;
            lf0[i] = LF[o + lane]; lf1[i] = LF[o + 64 + lane]; q0[i] = bf2f(QS[o + lane]); q1[i] = bf2f(QS[o + 64 + lane]); vv[i] = bf2f(VI[o + v]); }
        float res = 0.f;
#pragma unroll
        for (int i = 0; i < 16; ++i) {
            const float f0 = __expf(lf0[i]), f1 = __expf(lf1[i]);
            S0 = f0 * S0 + (1.f - f0) * vv[i]; S1 = f1 * S1 + (1.f - f1) * vv[i];
            const float p = wave_sum(q0[i] * S0 + q1[i] * S1);
            if (lane == i) res = p;
        }
        if (lane < 16) ORAW[(rb + t0 + lane) * 512 + h * 128 + v] = res;
    }
}
__device__ __forceinline__ void hgrn_finalize(const float* ORAW, const bf16* GT, const float* nw, bf16* O, int gw, int NGW, int lane) {
    asm volatile("" : "+v"(lane));
    for (int it = gw; it < M * 4; it += NGW) {
        const int row = it >> 2, h = it & 3; const size_t o = (size_t)row * 512 + h * 128 + 2 * lane;
        const float a = ORAW[o], c = ORAW[o + 1];
        const float ss = wave_sum(a * a + c * c);
        const float r = 1.0f / sqrtf(ss * (1.f / 128.f) + RMS_EPS);
        const unsigned gt = *(const unsigned*)(GT + o);
        const float y0 = a * r * nw[h * 128 + 2 * lane] * bflo(gt), y1 = c * r * nw[h * 128 + 2 * lane + 1] * bfhi(gt);
        *(unsigned*)(O + (size_t)row * D + h * 128 + 2 * lane) = pk2(y0, y1);
    }
}
__device__ __forceinline__ float dot8(v4u a, v4u b) {
    return bflo(a.x) * bflo(b.x) + bfhi(a.x) * bfhi(b.x) + bflo(a.y) * bflo(b.y) + bfhi(a.y) * bfhi(b.y) + bflo(a.z) * bflo(b.z) + bfhi(a.z) * bfhi(b.z) + bflo(a.w) * bflo(b.w) + bfhi(a.w) * bfhi(b.w);
}
__device__ __forceinline__ void attn_simple(const bf16* AQ, const bf16* AK, const bf16* AV, bf16* O, LAS float* pbuf, int gw, int NGW, int lane) {
    asm volatile("" : "+v"(lane));
    for (int it = gw; it < M * 8; it += NGW) {
        const int row = it >> 3, h = it & 7, b = row / SEQ, t = row % SEQ;
        const v4u* qp = (const v4u*)(AQ + (size_t)row * 512 + h * 64);
        v4u q[8];
#pragma unroll
        for (int i = 0; i < 8; ++i) q[i] = qp[i];
        float sc[6]; float mx = -INFINITY;
#pragma unroll
        for (int p = 0; p < 3; ++p) { const int d = p == 0 ? 1 : (p == 1 ? 4 : 16);
#pragma unroll
            for (int c = 0; c < 2; ++c) { const int j = 1 + 64 * c + lane; const int s = t - j * d; float a = -INFINITY;
                if (s >= 0) { const v4u* kp = (const v4u*)(AK + ((size_t)b * SEQ + s) * 512 + h * 64); a = 0.f;
#pragma unroll
                    for (int i = 0; i < 8; ++i) a += dot8(q[i], kp[i]); }
                sc[p * 2 + c] = a; mx = fmaxf(mx, a); } }
        float sself = 0.f; { const v4u* kp = (const v4u*)(AK + (size_t)row * 512 + h * 64);
#pragma unroll
            for (int i = 0; i < 8; ++i) sself += dot8(q[i], kp[i]); }
        mx = fmaxf(wave_max(mx), sself);
        float l = 0.f;
#pragma unroll
        for (int i = 0; i < 6; ++i) { const float e = __expf(sc[i] - mx); pbuf[i * 64 + lane] = e; l += e; }
        const float pself = 3.0f * __expf(sself - mx);
        l = wave_sum(l) + pself;
        LDS_WAIT(); asm volatile("" ::: "memory");
        float o = pself * bf2f(AV[(size_t)row * 512 + h * 64 + lane]);
#pragma unroll
        for (int p = 0; p < 3; ++p) { const int d = p == 0 ? 1 : (p == 1 ? 4 : 16);
            int jmax = t / d; if (jmax > 128) jmax = 128;
#pragma unroll 8
            for (int j = 1; j <= jmax; ++j) o += pbuf[p * 128 + j - 1] * bf2f(AV[((size_t)b * SEQ + t - j * d) * 512 + h * 64 + lane]);
        }
        O[(size_t)row * D + 512 + h * 64 + lane] = (bf16)f2bf(o / l);
        LDS_WAIT(); asm volatile("" ::: "memory");
    }
}

typedef float f32x16 __attribute__((ext_vector_type(16)));
typedef short v4i16_t __attribute__((ext_vector_type(4)));
constexpr int IMG_STRIDE = 16384 + 64, VHALF_BYTES = 2 * IMG_STRIDE;
__device__ __forceinline__ int crow(int r, int hi) { return (r & 3) + 8 * (r >> 2) + 4 * hi; }
__device__ __forceinline__ void attn_mfma(const bf16* AQ, const bf16* AK, const bf16* AV, bf16* O, bf16* XBp, float* ML, LAS unsigned char* L, int tid) {
    asm volatile("" : "+v"(tid));
    const int lane = tid & 63, wave = __builtin_amdgcn_readfirstlane(tid >> 6), half = wave >> 2, qi = wave & 3, l31 = lane & 31, hi = lane >> 5, ti = tid & 255;
    LAS unsigned char* Vimg = L + half * VHALF_BYTES;
    const int G = gridDim.x;
    for (int pair = blockIdx.x; pair < 3072; pair += G) {
        const int it = pair * 2 + half;
        const int bh = it / 384, rem = it - bh * 384, p = rem >> 7, c = rem & 127, sh = 2 * p, dil = 1 << sh, r = c & (dil - 1), n = c >> sh;
        const int b = bh >> 3, h = bh & 7;
        const size_t rowbase = (size_t)b * SEQ;
        __syncthreads();
#pragma unroll
        for (int k = 0; k < 8; ++k) {
            const int cid = ti + 256 * k, j = cid >> 3, cc = cid & 7; int m = 128 * (n - 1) + j; m = m < 0 ? 0 : m;
            const v4u v = *(const v4u*)(AV + (rowbase + (size_t)(m * dil + r)) * 512 + h * 64 + 8 * cc);
            *(LAS v4u*)(Vimg + (cc >> 2) * IMG_STRIDE + j * 64 + (cc & 3) * 16) = v;
        }
        const size_t qrow = rowbase + (size_t)((128 * n + 32 * qi + l31) * dil + r);
        bf16x8 qf[4];
        { const bf16x8* qp = (const bf16x8*)(AQ + qrow * 512 + h * 64 + 32 * hi);
#pragma unroll
          for (int ks = 0; ks < 4; ++ks) qf[ks] = qp[ks]; }
        f32x16 S[5];
#pragma unroll
        for (int kk = 0; kk < 5; ++kk) {
            int m = 128 * (n - 1) + 32 * (qi + kk) + l31; m = m < 0 ? 0 : m;
            const bf16x8* kp = (const bf16x8*)(AK + (rowbase + (size_t)(m * dil + r)) * 512 + h * 64 + 32 * hi);
            bf16x8 kf[4];
#pragma unroll
            for (int ks = 0; ks < 4; ++ks) kf[ks] = kp[ks];
            f32x16 a = {};
#pragma unroll
            for (int ks = 0; ks < 4; ++ks) a = __builtin_amdgcn_mfma_f32_32x32x16_bf16(kf[ks], qf[ks], a, 0, 0, 0);
            S[kk] = a;
        }
        float mx = -INFINITY;
#pragma unroll
        for (int kk = 0; kk < 5; ++kk)
#pragma unroll
            for (int jj = 0; jj < 16; ++jj) { const int kl = crow(jj, hi), jrel = 32 * kk + kl - l31;
                const bool valid = jrel >= 0 && jrel <= 128 && (n > 0 || 32 * (qi + kk) + kl >= 128);
                const float sv = valid ? S[kk][jj] : -INFINITY; S[kk][jj] = sv; mx = fmaxf(mx, sv); }
        mx = fmaxf(mx, __shfl_xor(mx, 32));
        float lsum = 0.f;
#pragma unroll
        for (int kk = 0; kk < 5; ++kk)
#pragma unroll
            for (int jj = 0; jj < 16; ++jj) { const float e = __builtin_amdgcn_exp2f(S[kk][jj] - mx); S[kk][jj] = e; lsum += e; }
        lsum += __shfl_xor(lsum, 32);
        __syncthreads();
        f32x16 o0 = {}, o1 = {};
        const int g = lane >> 4, q4 = (lane & 15) >> 2, p4 = lane & 3;
        const LAS unsigned char* vb = Vimg + (4 * (g >> 1) + q4) * 64 + (16 * (g & 1) + 4 * p4) * 2;
#pragma unroll
        for (int kk = 0; kk < 5; ++kk)
#pragma unroll
            for (int s2 = 0; s2 < 2; ++s2) {
                u32x4w pw; pw.x = pk2(S[kk][8 * s2 + 0], S[kk][8 * s2 + 1]); pw.y = pk2(S[kk][8 * s2 + 2], S[kk][8 * s2 + 3]); pw.z = pk2(S[kk][8 * s2 + 4], S[kk][8 * s2 + 5]); pw.w = pk2(S[kk][8 * s2 + 6], S[kk][8 * s2 + 7]);
                const bf16x8 pf = __builtin_bit_cast(bf16x8, pw);
                const LAS unsigned char* vk = vb + (32 * (qi + kk) + 16 * s2) * 64;
                const v4i16_t a00 = __builtin_amdgcn_ds_read_tr16_b64_v4i16((LAS v4i16_t*)(vk)), a01 = __builtin_amdgcn_ds_read_tr16_b64_v4i16((LAS v4i16_t*)(vk + 8 * 64));
                const v4i16_t a10 = __builtin_amdgcn_ds_read_tr16_b64_v4i16((LAS v4i16_t*)(vk + IMG_STRIDE)), a11 = __builtin_amdgcn_ds_read_tr16_b64_v4i16((LAS v4i16_t*)(vk + IMG_STRIDE + 8 * 64));
                const bf16x8 v0 = {a00[0], a00[1], a00[2], a00[3], a01[0], a01[1], a01[2], a01[3]}, v1 = {a10[0], a10[1], a10[2], a10[3], a11[0], a11[1], a11[2], a11[3]};
                o0 = __builtin_amdgcn_mfma_f32_32x32x16_bf16(v0, pf, o0, 0, 0, 0);
                o1 = __builtin_amdgcn_mfma_f32_32x32x16_bf16(v1, pf, o1, 0, 0, 0);
            }
        bf16* ob = p == 0 ? O + qrow * 1024 + 512 + h * 64 : XBp + (size_t)(p - 1) * ((size_t)M * 512) + qrow * 512 + h * 64;
#pragma unroll
        for (int g4 = 0; g4 < 4; ++g4) {
            v2u w0; w0.x = pk2(o0[4 * g4], o0[4 * g4 + 1]); w0.y = pk2(o0[4 * g4 + 2], o0[4 * g4 + 3]); *(v2u*)(ob + 8 * g4 + 4 * hi) = w0;
            v2u w1; w1.x = pk2(o1[4 * g4], o1[4 * g4 + 1]); w1.y = pk2(o1[4 * g4 + 2], o1[4 * g4 + 3]); *(v2u*)(ob + 32 + 8 * g4 + 4 * hi) = w1;
        }
        if (hi == 0) { float* mlp = ML + (((size_t)p * M + qrow) * 8 + h) * 2; mlp[0] = mx; mlp[1] = lsum; }
    }
}
__device__ __forceinline__ void attn_merge(bf16* O, const bf16* XBp, const float* ML, int gw, int NGW, int lane) {
    asm volatile("" : "+v"(lane));
    const int hh = lane >> 3, c8 = lane & 7;
    for (int row = gw; row < M; row += NGW) {
        float m[3], l[3];
#pragma unroll
        for (int p = 0; p < 3; ++p) { const float* mlp = ML + (((size_t)p * M + row) * 8 + hh) * 2; m[p] = mlp[0]; l[p] = mlp[1]; }
        const float ma = fmaxf(m[0], fmaxf(m[1], m[2]));
        float w[3], den = 0.f;
#pragma unroll
        for (int p = 0; p < 3; ++p) { w[p] = __builtin_amdgcn_exp2f(m[p] - ma); den += w[p] * l[p]; }
        const float inv = 1.0f / den;
        bf16* op = O + (size_t)row * 1024 + 512 + hh * 64 + 8 * c8;
        const v4u a = *(const v4u*)op, b1 = *(const v4u*)(XBp + (size_t)row * 512 + hh * 64 + 8 * c8), b2 = *(const v4u*)(XBp + (size_t)M * 512 + (size_t)row * 512 + hh * 64 + 8 * c8);
        v4u r;
        r.x = pk2((w[0] * bflo(a.x) + w[1] * bflo(b1.x) + w[2] * bflo(b2.x)) * inv, (w[0] * bfhi(a.x) + w[1] * bfhi(b1.x) + w[2] * bfhi(b2.x)) * inv);
        r.y = pk2((w[0] * bflo(a.y) + w[1] * bflo(b1.y) + w[2] * bflo(b2.y)) * inv, (w[0] * bfhi(a.y) + w[1] * bfhi(b1.y) + w[2] * bfhi(b2.y)) * inv);
        r.z = pk2((w[0] * bflo(a.z) + w[1] * bflo(b1.z) + w[2] * bflo(b2.z)) * inv, (w[0] * bfhi(a.z) + w[1] * bfhi(b1.z) + w[2] * bfhi(b2.z)) * inv);
        r.w = pk2((w[0] * bflo(a.w) + w[1] * bflo(b1.w) + w[2] * bflo(b2.w)) * inv, (w[0] * bfhi(a.w) + w[1] * bfhi(b1.w) + w[2] * bfhi(b2.w)) * inv);
        *(v4u*)op = r;
    }
}

constexpr int RS_T = 144, RS_C = 272;
constexpr int OFF_KD = 0, OFF_VT = 18432, OFF_QI = 36864, OFF_QM = 54272, OFF_KM = 71680, OFF_ST = 89088, OFF_PART = 123904, OFF_DVEC = 125952, OFF_SSQ = 126464;
template <int MODE>
__device__ __forceinline__ void hgrn_pass(const bf16* QS, const float* LF, const bf16* VI, const bf16* GT, const float* nw, float* STATE, float* DV, bf16* O, LAS unsigned char* L, int tid) {
    asm volatile("" : "+v"(tid));
    const int lane = tid & 63, wave = __builtin_amdgcn_readfirstlane(tid >> 6), l31 = lane & 31, hi = lane >> 5;
    const int c = tid & 127, tq = tid >> 7;
    const int vt = wave & 3, tt = wave >> 2, kt0 = 2 * (wave >> 2);
    LAS float* part = (LAS float*)(L + OFF_PART); LAS float* dvec = (LAS float*)(L + OFF_DVEC); LAS float* ssq = (LAS float*)(L + OFF_SSQ);
    for (int item = blockIdx.x; item < 512; item += gridDim.x) {
        const int bh = item >> 6, sc = item & 63, b = bh >> 2, h = bh & 3;
        const size_t row0 = (size_t)b * SEQ + sc * 256;
        f32x16 acc[2];
        if (MODE == 0) { acc[0] = (f32x16){}; acc[1] = (f32x16){}; }
        else {
#pragma unroll
            for (int kt2 = 0; kt2 < 2; ++kt2)
#pragma unroll
                for (int g4 = 0; g4 < 4; ++g4) {
                    const int v = 32 * vt + l31, k0 = 32 * (kt0 + kt2) + 8 * g4 + 4 * hi;
                    const f32x4 sv = *(const f32x4*)(STATE + (size_t)item * 16384 + v * 128 + k0);
                    acc[kt2][4 * g4 + 0] = sv[0]; acc[kt2][4 * g4 + 1] = sv[1]; acc[kt2][4 * g4 + 2] = sv[2]; acc[kt2][4 * g4 + 3] = sv[3];
                    v2u w; w.x = pk2(sv[0], sv[1]); w.y = pk2(sv[2], sv[3]);
                    *(LAS v2u*)(L + OFF_ST + v * RS_C + k0 * 2) = w;
                }
        }
        float gtot = 0.f;
        for (int ch = 0; ch < 4; ++ch) {
            const size_t rowc = row0 + ch * 64 + 16 * tq;
            float g[16], lfv[16]; unsigned short vv[16], qq[16];
            { const float* lfp = LF + rowc * 512 + h * 128 + c; const bf16* vp = VI + rowc * 512 + h * 128 + c; const bf16* qp = QS + rowc * 512 + h * 128 + c;
#pragma unroll
              for (int i = 0; i < 16; ++i) { lfv[i] = lfp[(size_t)i * 512]; vv[i] = vp[(size_t)i * 512]; if (MODE == 1) qq[i] = qp[(size_t)i * 512]; } }
            float run = 0.f;
#pragma unroll
            for (int i = 0; i < 16; ++i) { run += lfv[i]; g[i] = run; }
            part[tq * 128 + c] = run;
            { v4u w0, w1;
              w0.x = vv[0] | ((unsigned)vv[1] << 16); w0.y = vv[2] | ((unsigned)vv[3] << 16); w0.z = vv[4] | ((unsigned)vv[5] << 16); w0.w = vv[6] | ((unsigned)vv[7] << 16);
              w1.x = vv[8] | ((unsigned)vv[9] << 16); w1.y = vv[10] | ((unsigned)vv[11] << 16); w1.z = vv[12] | ((unsigned)vv[13] << 16); w1.w = vv[14] | ((unsigned)vv[15] << 16);
              *(LAS v4u*)(L + OFF_VT + c * RS_T + tq * 32) = w0; *(LAS v4u*)(L + OFF_VT + c * RS_T + tq * 32 + 16) = w1; }
            __syncthreads();
            const float p0 = part[c], p1 = part[128 + c], p2 = part[256 + c], p3 = part[384 + c];
            const float off = (tq > 0 ? p0 : 0.f) + (tq > 1 ? p1 : 0.f) + (tq > 2 ? p2 : 0.f);
            const float glast = (p0 + p1) + (p2 + p3), gmid = p0 + p1;
            if (tq == 0) { dvec[c] = __expf(glast); gtot += glast; }
            const float eLM = __expf(glast - gmid), emid = __expf(-gmid);
            unsigned kdw[8];
#pragma unroll
            for (int i = 0; i < 16; ++i) {
                const float G = off + g[i], f = __expf(lfv[i]), kk = 1.0f - f, km = kk * __expf(gmid - G), kd = km * eLM;
                if (i & 1) kdw[i >> 1] |= f2bf(kd) << 16; else kdw[i >> 1] = f2bf(kd);
                if (MODE == 1) {
                    const float qi = bf2f(qq[i]) * __expf(G), qm = qi * emid; const int t = 16 * tq + i;
                    *(LAS unsigned short*)(L + OFF_QI + t * RS_C + c * 2) = (unsigned short)f2bf(qi);
                    *(LAS unsigned short*)(L + OFF_QM + t * RS_C + c * 2) = (unsigned short)f2bf(qm);
                    *(LAS unsigned short*)(L + OFF_KM + t * RS_C + c * 2) = (unsigned short)f2bf(km);
                }
            }
            { v4u w0, w1; w0.x = kdw[0]; w0.y = kdw[1]; w0.z = kdw[2]; w0.w = kdw[3]; w1.x = kdw[4]; w1.y = kdw[5]; w1.z = kdw[6]; w1.w = kdw[7];
              *(LAS v4u*)(L + OFF_KD + c * RS_T + tq * 32) = w0; *(LAS v4u*)(L + OFF_KD + c * RS_T + tq * 32 + 16) = w1; }
            __syncthreads();
            if (MODE == 1) {
                f32x16 Pd = (f32x16){}, P0 = (f32x16){};
#pragma unroll
                for (int ks = 0; ks < 8; ++ks) {
                    const bf16x8 bq = *(const LAS bf16x8*)(L + OFF_QM + (32 * tt + l31) * RS_C + (16 * ks + 8 * hi) * 2);
                    const bf16x8 ad = *(const LAS bf16x8*)(L + OFF_KM + (32 * tt + l31) * RS_C + (16 * ks + 8 * hi) * 2);
                    Pd = __builtin_amdgcn_mfma_f32_32x32x16_bf16(ad, bq, Pd, 0, 0, 0);
                    if (tt == 1) { const bf16x8 a0 = *(const LAS bf16x8*)(L + OFF_KM + l31 * RS_C + (16 * ks + 8 * hi) * 2); P0 = __builtin_amdgcn_mfma_f32_32x32x16_bf16(a0, bq, P0, 0, 0, 0); }
                }
#pragma unroll
                for (int jj = 0; jj < 16; ++jj) if (crow(jj, hi) > l31) Pd[jj] = 0.f;
                f32x16 oT = (f32x16){};
#pragma unroll
                for (int ks = 0; ks < 8; ++ks) {
                    const bf16x8 as = *(const LAS bf16x8*)(L + OFF_ST + (32 * vt + l31) * RS_C + (16 * ks + 8 * hi) * 2);
                    const bf16x8 bq = *(const LAS bf16x8*)(L + OFF_QI + (32 * tt + l31) * RS_C + (16 * ks + 8 * hi) * 2);
                    oT = __builtin_amdgcn_mfma_f32_32x32x16_bf16(as, bq, oT, 0, 0, 0);
                }
#pragma unroll
                for (int s2 = 0; s2 < 2; ++s2) {
                    u32x4w pw; pw.x = pk2(Pd[8 * s2 + 0], Pd[8 * s2 + 1]); pw.y = pk2(Pd[8 * s2 + 2], Pd[8 * s2 + 3]); pw.z = pk2(Pd[8 * s2 + 4], Pd[8 * s2 + 5]); pw.w = pk2(Pd[8 * s2 + 6], Pd[8 * s2 + 7]);
                    const LAS unsigned char* vp = L + OFF_VT + (32 * vt + l31) * RS_T + (32 * tt + 16 * s2 + 4 * hi) * 2;
                    const v2u x0 = *(const LAS v2u*)vp, x1 = *(const LAS v2u*)(vp + 16);
                    u32x4w aw; aw.x = x0.x; aw.y = x0.y; aw.z = x1.x; aw.w = x1.y;
                    oT = __builtin_amdgcn_mfma_f32_32x32x16_bf16(__builtin_bit_cast(bf16x8, aw), __builtin_bit_cast(bf16x8, pw), oT, 0, 0, 0);
                }
                if (tt == 1) {
#pragma unroll
                    for (int s2 = 0; s2 < 2; ++s2) {
                        u32x4w pw; pw.x = pk2(P0[8 * s2 + 0], P0[8 * s2 + 1]); pw.y = pk2(P0[8 * s2 + 2], P0[8 * s2 + 3]); pw.z = pk2(P0[8 * s2 + 4], P0[8 * s2 + 5]); pw.w = pk2(P0[8 * s2 + 6], P0[8 * s2 + 7]);
                        const LAS unsigned char* vp = L + OFF_VT + (32 * vt + l31) * RS_T + (16 * s2 + 4 * hi) * 2;
                        const v2u x0 = *(const LAS v2u*)vp, x1 = *(const LAS v2u*)(vp + 16);
                        u32x4w aw; aw.x = x0.x; aw.y = x0.y; aw.z = x1.x; aw.w = x1.y;
                        oT = __builtin_amdgcn_mfma_f32_32x32x16_bf16(__builtin_bit_cast(bf16x8, aw), __builtin_bit_cast(bf16x8, pw), oT, 0, 0, 0);
                    }
                }
                float sq = 0.f;
#pragma unroll
                for (int jj = 0; jj < 16; ++jj) sq += oT[jj] * oT[jj];
                sq += __shfl_xor(sq, 32);
                if (hi == 0) ssq[vt * 64 + 32 * tt + l31] = sq;
                __syncthreads();
                const int tl = 32 * tt + l31;
                const float tot = (ssq[tl] + ssq[64 + tl]) + (ssq[128 + tl] + ssq[192 + tl]);
                const float rstd = 1.0f / sqrtf(tot * (1.0f / 128.0f) + RMS_EPS);
                const size_t rowt = row0 + ch * 64 + tl;
#pragma unroll
                for (int g4 = 0; g4 < 4; ++g4) {
                    const int v0 = 32 * vt + 8 * g4 + 4 * hi;
                    const f32x4 nv = *(const f32x4*)(nw + h * 128 + v0);
                    const v2u gt = *(const v2u*)(GT + rowt * 512 + h * 128 + v0);
                    v2u w; w.x = pk2(oT[4 * g4] * rstd * nv[0] * bflo(gt.x), oT[4 * g4 + 1] * rstd * nv[1] * bfhi(gt.x));
                    w.y = pk2(oT[4 * g4 + 2] * rstd * nv[2] * bflo(gt.y), oT[4 * g4 + 3] * rstd * nv[3] * bfhi(gt.y));
                    *(v2u*)(O + rowt * 1024 + h * 128 + v0) = w;
                }
            }
#pragma unroll
            for (int kt2 = 0; kt2 < 2; ++kt2) {
                const int kt = kt0 + kt2;
#pragma unroll
                for (int g4 = 0; g4 < 4; ++g4) { const f32x4 dv = *(const LAS f32x4*)(dvec + 32 * kt + 8 * g4 + 4 * hi);
                    acc[kt2][4 * g4] *= dv[0]; acc[kt2][4 * g4 + 1] *= dv[1]; acc[kt2][4 * g4 + 2] *= dv[2]; acc[kt2][4 * g4 + 3] *= dv[3]; }
#pragma unroll
                for (int ts = 0; ts < 4; ++ts) {
                    const bf16x8 a = *(const LAS bf16x8*)(L + OFF_KD + (32 * kt + l31) * RS_T + (16 * ts + 8 * hi) * 2);
                    const bf16x8 bb = *(const LAS bf16x8*)(L + OFF_VT + (32 * vt + l31) * RS_T + (16 * ts + 8 * hi) * 2);
                    acc[kt2] = __builtin_amdgcn_mfma_f32_32x32x16_bf16(a, bb, acc[kt2], 0, 0, 0);
                }
                if (MODE == 1) {
#pragma unroll
                    for (int g4 = 0; g4 < 4; ++g4) { v2u w; w.x = pk2(acc[kt2][4 * g4], acc[kt2][4 * g4 + 1]); w.y = pk2(acc[kt2][4 * g4 + 2], acc[kt2][4 * g4 + 3]);
                        *(LAS v2u*)(L + OFF_ST + (32 * vt + l31) * RS_C + (32 * kt + 8 * g4 + 4 * hi) * 2) = w; }
                }
            }
            __syncthreads();
        }
        if (MODE == 0) {
#pragma unroll
            for (int kt2 = 0; kt2 < 2; ++kt2)
#pragma unroll
                for (int g4 = 0; g4 < 4; ++g4) {
                    const int v = 32 * vt + l31, k0 = 32 * (kt0 + kt2) + 8 * g4 + 4 * hi;
                    *(f32x4*)(STATE + (size_t)item * 16384 + v * 128 + k0) = (f32x4){acc[kt2][4 * g4], acc[kt2][4 * g4 + 1], acc[kt2][4 * g4 + 2], acc[kt2][4 * g4 + 3]};
                }
            if (tq == 0) DV[item * 128 + c] = __expf(gtot);
        }
    }
}
__device__ __forceinline__ void hgrn_scan(float* STATE, const float* DV, int tid) {
    asm volatile("" : "+v"(tid));
    for (int e = blockIdx.x * 512 + tid; e < 8 * 16384; e += gridDim.x * 512) {
        const int bh = e >> 14, vk = e & 16383, k = vk & 127;
        float S = 0.f;
        for (int sc0 = 0; sc0 < 64; sc0 += 16) {
            float lv[16], dv[16];
#pragma unroll
            for (int i = 0; i < 16; ++i) { const size_t item = (size_t)bh * 64 + sc0 + i; lv[i] = STATE[item * 16384 + vk]; dv[i] = DV[item * 128 + k]; }
#pragma unroll
            for (int i = 0; i < 16; ++i) { const size_t item = (size_t)bh * 64 + sc0 + i; STATE[item * 16384 + vk] = S; S = dv[i] * S + lv[i]; }
        }
    }
}

__global__ void __launch_bounds__(512, 2) fwd_mega(Args args) {
    extern __shared__ __attribute__((aligned(16))) unsigned char lds[];
    cg::grid_group grid = cg::this_grid();
    LAS unsigned char* L = (LAS unsigned char*)lds;
    const int tid = threadIdx.x, lane = tid & 63, wave = __builtin_amdgcn_readfirstlane(tid >> 6);
    const int G = gridDim.x, gw = blockIdx.x * NWAVES + wave, NGW = G * NWAVES;
    unsigned char* ws = args.ws;
    const float* x_in = args.in[0];
    bf16* XB = (bf16*)(ws + WS_XB);
    bf16* SEGB = (bf16*)(ws + WS_A);
    bf16* QS = SEGB; bf16* VI = SEGB + 1 * (SEG_BYTES / 2); bf16* GT = SEGB + 2 * (SEG_BYTES / 2);
    bf16* AQ = SEGB + 3 * (SEG_BYTES / 2); bf16* AK = SEGB + 4 * (SEG_BYTES / 2); bf16* AV = SEGB + 5 * (SEG_BYTES / 2);
    float* LF = (float*)(ws + WS_LF);
    float* Y = (float*)(ws + WS_A);
    bf16* H = (bf16*)(ws + WS_A);
    bf16* O = (bf16*)(ws + WS_B);
    float* ORAW = (float*)(ws + WS_ORAW);
    float* Y2 = (float*)(ws + WS_B);
    float* out = args.out;

    {
        LAS float* scr = (LAS float*)(L + wave * 16384);
        for (int l = 0; l < DEPTH; ++l) {
            bf16* wl = (bf16*)(ws + WS_W + l * W_LAYER);
            constexpr int I_IN = (D / 64) * (NIN / 32), I_O = (D / 64) * (D / 32), I_1 = (D / 64) * (FF / 32), I_2 = (FF / 64) * (D / 32);
            for (int it = gw; it < I_IN + I_O + I_1 + I_2; it += NGW) {
                int r = it;
                if (r < I_IN) { p0_transpose_item(args.in[1] + (size_t)l * D * NIN, D, NIN, wl + W_IN / 2, scr, r, lane); continue; } r -= I_IN;
                if (r < I_O) { p0_transpose_item(args.in[2] + (size_t)l * D * D, D, D, wl + W_O / 2, scr, r, lane); continue; } r -= I_O;
                if (r < I_1) { p0_transpose_item(args.in[7] + (size_t)l * D * FF, D, FF, wl + W_1 / 2, scr, r, lane); continue; } r -= I_1;
                p0_transpose_item(args.in[8] + (size_t)l * FF * D, FF, D, wl + W_2 / 2, scr, r, lane);
            }
        }
        for (size_t i = (size_t)blockIdx.x * 512 + tid; i < (size_t)M * D / 4; i += (size_t)G * 512) {
            const f32x4 v = ((const f32x4*)x_in)[i]; v2u w; w.x = pk2(v.x, v.y); w.y = pk2(v.z, v.w); ((v2u*)XB)[i] = w; }
    }
    grid.sync();

    for (int l = 0; l < DEPTH; ++l) {
        const bf16* wl = (const bf16*)(ws + WS_W + l * W_LAYER);
        const float* res0 = l == 0 ? x_in : out;
        {
            pg8::Gemm g{XB, wl + W_IN / 2, M, NIN, D}; pg8::StaticOrder S; { int bx = blockIdx.x, Gs = G; asm volatile("" : "+s"(bx), "+s"(Gs)); S.init(M, NIN, Gs, bx); }
            pg8::EpiInProj E{SEGB, LF, args.in[3], args.in[3] + HW, l};
            pg8::gemm_phase<pg8::EpiInProj, pg8::StaticOrder, true, true>(L, g, S, E);
        }
        grid.sync();
        hgrn_pass<0>(QS, LF, VI, GT, args.in[4] + l * HW, ORAW, (float*)(ws + WS_DV), O, L, tid);
        attn_mfma(AQ, AK, AV, O, XB, (float*)(ws + WS_ML), L, tid);
        grid.sync();
        hgrn_scan(ORAW, (const float*)(ws + WS_DV), tid);
        attn_merge(O, XB, (const float*)(ws + WS_ML), gw, NGW, lane);
        grid.sync();
        hgrn_pass<1>(QS, LF, VI, GT, args.in[4] + l * HW, ORAW, (float*)(ws + WS_DV), O, L, tid);
        grid.sync();
        {
            pg8::Gemm g{O, wl + W_O / 2, M, D, D}; pg8::StaticOrder S; { int bx = blockIdx.x, Gs = G; asm volatile("" : "+s"(bx), "+s"(Gs)); S.init(M, D, Gs, bx); }
            pg8::EpiResid E{res0, Y, ALPHA};
            pg8::gemm_phase<pg8::EpiResid, pg8::StaticOrder, true, true>(L, g, S, E);
        }
        grid.sync();
        ln_rows(Y, out, XB, args.in[5] + l * D, args.in[6] + l * D, gw, NGW, lane);
        grid.sync();
        {
            pg8::Gemm g{XB, wl + W_1 / 2, M, FF, D}; pg8::StaticOrder S; { int bx = blockIdx.x, Gs = G; asm volatile("" : "+s"(bx), "+s"(Gs)); S.init(M, FF, Gs, bx); }
            pg8::EpiSqRelu E{H};
            pg8::gemm_phase<pg8::EpiSqRelu, pg8::StaticOrder, true, true>(L, g, S, E);
        }
        grid.sync();
        {
            pg8::Gemm g{H, wl + W_2 / 2, M, D, FF}; pg8::StaticOrder S; { int bx = blockIdx.x, Gs = G; asm volatile("" : "+s"(bx), "+s"(Gs)); S.init(M, D, Gs, bx); }
            pg8::EpiResid E{out, Y2, ALPHA};
            pg8::gemm_phase<pg8::EpiResid, pg8::StaticOrder, true, true>(L, g, S, E);
        }
        grid.sync();
        ln_rows(Y2, out, XB, args.in[9] + l * D, args.in[10] + l * D, gw, NGW, lane);
        if (l + 1 < DEPTH) grid.sync();
    }
}

extern "C" void kernel_launch(void* const* d_in, const int* in_sizes, int n_in, void* d_out, int out_size, void* d_ws, size_t ws_size, hipStream_t stream) {
    static int grid = 0;
    if (grid == 0) {
        if (n_in != 11 || in_sizes[0] != M * D || out_size != M * D || ws_size < WS_END) { fprintf(stderr, "kernel_launch: unexpected shapes / workspace (%d inputs, ws %zu)\n", n_in, ws_size); grid = -1; return; }
        int dev = 0, cus = 0, per_cu = 0;
        hipGetDevice(&dev); hipDeviceGetAttribute(&cus, hipDeviceAttributeMultiprocessorCount, dev);
        hipFuncSetAttribute((const void*)fwd_mega, hipFuncAttributeMaxDynamicSharedMemorySize, LDS_BYTES);
        hipOccupancyMaxActiveBlocksPerMultiprocessor(&per_cu, (const void*)fwd_mega, 512, LDS_BYTES);
        if (per_cu < 1) per_cu = 1;
        grid = cus;
        (void)hipGetLastError();
    }
    if (grid < 0) return;
    Args a{};
    for (int i = 0; i < 11; ++i) a.in[i] = (const float*)d_in[i];
    a.out = (float*)d_out; a.ws = (unsigned char*)d_ws;
    void* kargs[] = {&a};
    hipError_t e = hipLaunchCooperativeKernel((const void*)fwd_mega, dim3(grid), dim3(512), kargs, LDS_BYTES, stream);
    if (e != hipSuccess) fprintf(stderr, "cooperative launch failed: %s (grid %d)\n", hipGetErrorString(e), grid);
}
```

```cpp
#include <hip/hip_runtime.h>
#include <cstdio>
#include <cstdint>
namespace pg8 {
#define PG8_LAS __attribute__((address_space(3)))
typedef unsigned short bf16_t;
typedef short bf16x8 __attribute__((ext_vector_type(8)));
typedef float f32x4 __attribute__((ext_vector_type(4)));
typedef unsigned u32x4 __attribute__((ext_vector_type(4)));
constexpr int BM = 256, BK = 64, HALF = 128, HTB = HALF * BK * 2  , STAGE_BYTES = 8 * HTB, NXCD = 8, WGM = 8;

__host__ __device__ __forceinline__ int lds_byte(int r, int c) { const int st = (r >> 4) * 2 + (c >> 5), rr = r & 15, cc = c & 31, ob = rr * 64 + cc * 2; return st * 1024 + (ob ^ (((ob >> 9) & 1) << 5)); }
__host__ __device__ __forceinline__ void stage_rc(int b, int& R, int& C) { const int st = b / 1024, sb = b % 1024, swz = sb ^ (((sb >> 9) & 1) << 5); R = (st >> 1) * 16 + swz / 64; C = (st & 1) * 32 + (swz % 64) / 2; }
__host__ __device__ __forceinline__ int perm32(int rho) { const int n = rho >> 4, i = rho & 15; return 8 * (i >> 2) + 4 * n + (i & 3); }

struct Unit { int pm, pn; };
struct Gemm { const bf16_t* A; const bf16_t* Bt; int M, N, K; };

struct StaticOrder {
    int nM, nN, nwg, G, c;
    __host__ __device__ void init(int M, int N, int G_, int c_) { nM = M / BM; nN = N / BM; nwg = nM * nN; G = G_; c = c_; }
    __host__ __device__ bool next(int i, Unit& u) const {
        const long L = (long)i * G + c; if (L >= nwg) return false;
        int wgid = (int)L; { const int q = nwg / NXCD, r = nwg % NXCD, xcd = wgid % NXCD, off = wgid / NXCD; wgid = (xcd < r ? xcd * (q + 1) : r * (q + 1) + (xcd - r) * q) + off; }
        const int nig = WGM * nN, gid = wgid / nig, fm = gid * WGM, gsz = (nM - fm) < WGM ? (nM - fm) : WGM;
        u.pm = fm + ((wgid % nig) % gsz); u.pn = (wgid % nig) / gsz; return true;
    }
    __device__ __forceinline__ void a_ready(const Unit&) const {}
    __device__ __forceinline__ void done(const Unit&) const {}
};

__device__ __forceinline__ unsigned cvt_pk_bf16(float lo, float hi) { unsigned r; asm volatile("v_cvt_pk_bf16_f32 %0, %1, %2" : "=v"(r) : "v"(lo), "v"(hi)); return r; }
typedef float f32x2 __attribute__((ext_vector_type(2)));
__device__ __forceinline__ f32x2 gelu_pk(f32x2 v) {
    const f32x2 av = __builtin_elementwise_abs(v), d = av * 0.2316418882f + 1.0f;
    f32x2 t; t.x = __builtin_amdgcn_rcpf(d.x); t.y = __builtin_amdgcn_rcpf(d.y);
    f32x2 q = t * 0.5307027145f + (-0.7265760135f); q = q * t + 0.7107068705f; q = q * t + (-0.142248368f); q = q * t + 0.127414796f; q = q * t;
    const f32x2 s = (v * v) * (-0.72134752044f);
    f32x2 e; e.x = __builtin_amdgcn_exp2f(s.x); e.y = __builtin_amdgcn_exp2f(s.y);
    const f32x2 m = v * (q * e), r = v - m;
    f32x2 o; o.x = v.x < 0.f ? m.x : r.x; o.y = v.y < 0.f ? m.y : r.y; return o;
}

template <int ACT  > struct EpiBf16 {
    static constexpr bool PERM = true, AFTER_DRAIN = false; static_assert(ACT == 0 || ACT == 1, "EpiBf16: ACT is 0 (none) or 1 (gelu_pk)");
    bf16_t* O; int ldc; const float* bias; int split_cols; size_t split_stride; float scale0;
    __device__ __forceinline__ void operator()(const f32x4 (&acc)[2][2][4][2], const Unit& u, int wr, int wc, int fr, int fq) const {
        const int row0 = u.pm * BM + wr * 64 + fr; int colt = u.pn * BM; bf16_t* base = O;
        float sc = 1.f; if (split_cols) { const int t = colt / split_cols; base += (size_t)t * split_stride; colt -= t * split_cols; if (t == 0) sc = scale0; }
        const int col0 = colt + wc * 32 + 8 * fq, bcol0 = u.pn * BM + wc * 32 + 8 * fq;
        f32x4 bv[2][2];
#pragma unroll
        for (int bj = 0; bj < 2; ++bj)
#pragma unroll
            for (int n = 0; n < 2; ++n) bv[bj][n] = bias ? *(const f32x4*)(bias + bcol0 + bj * HALF + 4 * n) : (f32x4){0.f, 0.f, 0.f, 0.f};
#pragma unroll
        for (int ai = 0; ai < 2; ++ai)
#pragma unroll
            for (int m = 0; m < 4; ++m) { bf16_t* rowp = base + (size_t)(row0 + ai * HALF + m * 16) * ldc + col0;
#pragma unroll
                for (int bj = 0; bj < 2; ++bj) { f32x4 v0 = acc[ai][bj][m][0] + bv[bj][0], v1 = acc[ai][bj][m][1] + bv[bj][1];
                    if (ACT == 1) { f32x2 a = gelu_pk((f32x2){v0[0], v0[1]}), b = gelu_pk((f32x2){v0[2], v0[3]}), c = gelu_pk((f32x2){v1[0], v1[1]}), d = gelu_pk((f32x2){v1[2], v1[3]});
                        v0 = (f32x4){a.x, a.y, b.x, b.y}; v1 = (f32x4){c.x, c.y, d.x, d.y}; }
                    v0 = v0 * sc; v1 = v1 * sc; u32x4 w; w.x = cvt_pk_bf16(v0[0], v0[1]); w.y = cvt_pk_bf16(v0[2], v0[3]); w.z = cvt_pk_bf16(v1[0], v1[1]); w.w = cvt_pk_bf16(v1[2], v1[3]);
                    *(u32x4*)(rowp + bj * HALF) = w; } }
    }
};

struct PanelStats {
    unsigned* xbuf;
    unsigned* cnt;
    unsigned* tmo;
    int ntn; float eps;
    unsigned code;
    __device__ __forceinline__ bool run(const f32x4 (&v)[2][2][4][2], const Unit& u, int wr, int wc, int fr, int fq, PG8_LAS unsigned char* lds, int wid, int lane) const {
        typedef float f32x2v __attribute__((ext_vector_type(2)));
        PG8_LAS f32x2v* P = (PG8_LAS f32x2v*)lds;
        PG8_LAS f32x2v* S = (PG8_LAS f32x2v*)(lds + 8192);
        PG8_LAS unsigned* flag = (PG8_LAS unsigned*)(lds + 8192 + 2048);
#pragma unroll
        for (int ai = 0; ai < 2; ++ai)
#pragma unroll
            for (int m = 0; m < 4; ++m) {
                float s = 0.f;
#pragma unroll
                for (int bj = 0; bj < 2; ++bj)
#pragma unroll
                    for (int n = 0; n < 2; ++n) { const f32x4 x = v[ai][bj][m][n]; s += (x[0] + x[1]) + (x[2] + x[3]); }
                s += __shfl_xor(s, 16); s += __shfl_xor(s, 32);
                const float mw = s * (1.0f / 64.0f); float q = 0.f;
#pragma unroll
                for (int bj = 0; bj < 2; ++bj)
#pragma unroll
                    for (int n = 0; n < 2; ++n) { const f32x4 d = v[ai][bj][m][n] - mw; q += (d[0] * d[0] + d[1] * d[1]) + (d[2] * d[2] + d[3] * d[3]); }
                q += __shfl_xor(q, 16); q += __shfl_xor(q, 32);
                if (fq == 0) P[(ai * HALF + wr * 64 + m * 16 + fr) * 4 + wc] = (f32x2v){mw, q};
            }
        asm volatile("s_waitcnt lgkmcnt(0)" ::: "memory"); __builtin_amdgcn_s_barrier(); asm volatile("" ::: "memory");
#if defined(BROKEN_EXCHANGE_NO_WAIT)
#warning BROKEN CONTROL BUILD: the row-statistics exchange does not wait; results are wrong by design
        if (blockIdx.x >= 64) { const long long t0_ = clock64(); while (clock64() - t0_ < 60000) __builtin_amdgcn_s_sleep(8); }
#endif
        const int row = wid * 32 + (lane & 31);
        if (lane < 32) {
            const f32x2v a = P[row * 4 + 0], b = P[row * 4 + 1], c = P[row * 4 + 2], d = P[row * 4 + 3];
            const float mt = (a.x + b.x + c.x + d.x) * 0.25f;
            const float da = a.x - mt, db = b.x - mt, dc = c.x - mt, dd = d.x - mt;
            const float m2 = (a.y + b.y) + (c.y + d.y) + 64.0f * ((da * da + db * db) + (dc * dc + dd * dd));
            unsigned long long* slot = (unsigned long long*)xbuf + ((size_t)(u.pm * BM + row) * 4 + u.pn);
            __hip_atomic_store(slot, ((unsigned long long)__float_as_uint(m2) << 32) | __float_as_uint(mt), __ATOMIC_RELAXED, __HIP_MEMORY_SCOPE_AGENT);
        }
        asm volatile("s_waitcnt vmcnt(0)" ::: "memory");
        if (lane == 0) __hip_atomic_fetch_add(cnt + 64 * u.pm, 1u, __ATOMIC_RELAXED, __HIP_MEMORY_SCOPE_AGENT);
        if (wid == 0) {
            bool dead = false; const unsigned long long t0 = __builtin_amdgcn_s_memrealtime(); const unsigned want = 8u * (unsigned)ntn;
            for (;;) {
#if defined(BROKEN_EXCHANGE_NO_WAIT)
                break;
#endif
                if ((unsigned)__builtin_amdgcn_readfirstlane(__hip_atomic_load(cnt + 64 * u.pm, __ATOMIC_RELAXED, __HIP_MEMORY_SCOPE_AGENT)) >= want) break;
                if (__builtin_amdgcn_s_memrealtime() - t0 > 2000000ull) {
                    if (lane == 0) { unsigned expect = 0u; __hip_atomic_compare_exchange_strong(tmo + 1, &expect, code | (unsigned)(u.pm & 0xff), __ATOMIC_RELAXED, __ATOMIC_RELAXED, __HIP_MEMORY_SCOPE_AGENT);
                                     __hip_atomic_store(tmo, 1u, __ATOMIC_RELAXED, __HIP_MEMORY_SCOPE_AGENT); }
                    dead = true; break; }
                __builtin_amdgcn_s_sleep(2);
            }
            __builtin_amdgcn_fence(__ATOMIC_ACQUIRE, "agent");
            if (lane == 0) flag[0] = dead ? 1u : 0u;
        }
        asm volatile("s_waitcnt vmcnt(0) lgkmcnt(0)" ::: "memory"); __builtin_amdgcn_s_barrier(); asm volatile("" ::: "memory");
        const bool bad = flag[0] != 0u;
        if (lane < 32) {
            const unsigned long long* slot = (const unsigned long long*)xbuf + (size_t)(u.pm * BM + row) * 4; float mt[4], m2[4]; float ms = 0.f;
#pragma unroll
            for (int t = 0; t < 4; ++t) { if (t < ntn) { const unsigned long long w = __hip_atomic_load(slot + t, __ATOMIC_RELAXED, __HIP_MEMORY_SCOPE_AGENT); mt[t] = __uint_as_float((unsigned)w); m2[t] = __uint_as_float((unsigned)(w >> 32)); } else { mt[t] = 0.f; m2[t] = 0.f; } ms += mt[t]; }
            const float mean = ms / (float)ntn; float q = 0.f;
#pragma unroll
            for (int t = 0; t < 4; ++t) if (t < ntn) { const float dm = mt[t] - mean; q += m2[t] + 256.0f * dm * dm; }
            S[row] = (f32x2v){mean, 1.0f / sqrtf(q / (256.0f * (float)ntn) + eps)};
        }
        asm volatile("s_waitcnt lgkmcnt(0)" ::: "memory"); __builtin_amdgcn_s_barrier(); asm volatile("" ::: "memory");
        return bad;
    }
};
struct EpiLnRes {
    static constexpr bool PERM = false, AFTER_DRAIN = true;
    const float* base; float* out; int ldc; const float* bias; PanelStats st; unsigned poison;
    __device__ __forceinline__ void fused(f32x4 (&acc)[2][2][4][2], const Unit& u, int wr, int wc, int fr, int fq, PG8_LAS unsigned char* lds, int wid, int lane) const {
        typedef float f32x2v __attribute__((ext_vector_type(2)));
        const PG8_LAS f32x2v* S = (const PG8_LAS f32x2v*)(lds + 8192);
        const int col0 = u.pn * BM + wc * 32 + 4 * fq;
#pragma unroll
        for (int bj = 0; bj < 2; ++bj)
#pragma unroll
            for (int n = 0; n < 2; ++n) { const f32x4 bv = bias ? *(const f32x4*)(bias + col0 + bj * HALF + n * 16) : (f32x4){0.f, 0.f, 0.f, 0.f};
#pragma unroll
                for (int ai = 0; ai < 2; ++ai)
#pragma unroll
                    for (int m = 0; m < 4; ++m) acc[ai][bj][m][n] += bv; }
        f32x4 pre[4][2][2];
#pragma unroll
        for (int m = 0; m < 4; ++m) { const size_t off = (size_t)(u.pm * BM + wr * 64 + m * 16 + fr) * ldc + col0;
#pragma unroll
            for (int bj = 0; bj < 2; ++bj)
#pragma unroll
                for (int n = 0; n < 2; ++n) pre[m][bj][n] = *(const f32x4*)(base + off + bj * HALF + n * 16); }
        const bool bad = st.run(acc, u, wr, wc, fr, fq, lds, wid, lane) || poison != 0u;
        const float qnan = __builtin_nanf("");
#pragma unroll
        for (int ai = 0; ai < 2; ++ai)
#pragma unroll
            for (int m = 0; m < 4; ++m) { const int r = ai * HALF + wr * 64 + m * 16 + fr; const f32x2v sr = S[r]; const size_t off = (size_t)(u.pm * BM + r) * ldc + col0;
#pragma unroll
                for (int bj = 0; bj < 2; ++bj)
#pragma unroll
                    for (int n = 0; n < 2; ++n) { const f32x4 bs = ai == 0 ? pre[m][bj][n] : *(const f32x4*)(base + off + bj * HALF + n * 16); f32x4 o = bs + (acc[ai][bj][m][n] - sr.x) * sr.y;
                        if (bad) o = (f32x4){qnan, qnan, qnan, qnan}; *(f32x4*)(out + off + bj * HALF + n * 16) = o; }
                if (m & 1) asm volatile("" ::: "memory"); }
    }
};
struct EpiLnResLn {
    static constexpr bool PERM = false, AFTER_DRAIN = true;
    const float* base; float* out; bf16_t* xn; int ldc; const float* bias; PanelStats st1, st2; unsigned poison;
    __device__ __forceinline__ void fused(f32x4 (&acc)[2][2][4][2], const Unit& u, int wr, int wc, int fr, int fq, PG8_LAS unsigned char* lds, int wid, int lane) const {
        typedef float f32x2v __attribute__((ext_vector_type(2))); typedef unsigned u32x2v __attribute__((ext_vector_type(2)));
        const PG8_LAS f32x2v* S = (const PG8_LAS f32x2v*)(lds + 8192);
        const int col0 = u.pn * BM + wc * 32 + 4 * fq;
#pragma unroll
        for (int bj = 0; bj < 2; ++bj)
#pragma unroll
            for (int n = 0; n < 2; ++n) { const f32x4 bv = bias ? *(const f32x4*)(bias + col0 + bj * HALF + n * 16) : (f32x4){0.f, 0.f, 0.f, 0.f};
#pragma unroll
                for (int ai = 0; ai < 2; ++ai)
#pragma unroll
                    for (int m = 0; m < 4; ++m) acc[ai][bj][m][n] += bv; }
        bool bad = st1.run(acc, u, wr, wc, fr, fq, lds, wid, lane) || poison != 0u;
        const float qnan = __builtin_nanf("");
#pragma unroll
        for (int ai = 0; ai < 2; ++ai)
#pragma unroll
            for (int m = 0; m < 4; ++m) { const int r = ai * HALF + wr * 64 + m * 16 + fr; const f32x2v sr = S[r]; const size_t off = (size_t)(u.pm * BM + r) * ldc + col0;
#pragma unroll
                for (int bj = 0; bj < 2; ++bj)
#pragma unroll
                    for (int n = 0; n < 2; ++n) { const f32x4 bs = *(const f32x4*)(base + off + bj * HALF + n * 16); acc[ai][bj][m][n] = bs + (acc[ai][bj][m][n] - sr.x) * sr.y; }
                asm volatile("" : "+v"(acc[ai][0][m][0]), "+v"(acc[ai][0][m][1]), "+v"(acc[ai][1][m][0]), "+v"(acc[ai][1][m][1]));
                if (m & 1) asm volatile("" ::: "memory"); }
        const bool bad1 = bad;
        bad = st2.run(acc, u, wr, wc, fr, fq, lds, wid, lane) || bad;
#pragma unroll
        for (int ai = 0; ai < 2; ++ai)
#pragma unroll
            for (int m = 0; m < 4; ++m) { const int r = ai * HALF + wr * 64 + m * 16 + fr; const f32x2v sr = S[r]; const size_t off = (size_t)(u.pm * BM + r) * ldc + col0;
#pragma unroll
                for (int bj = 0; bj < 2; ++bj)
#pragma unroll
                    for (int n = 0; n < 2; ++n) { const f32x4 x1 = acc[ai][bj][m][n]; *(f32x4*)(out + off + bj * HALF + n * 16) = bad1 ? (f32x4){qnan, qnan, qnan, qnan} : x1;
                        const f32x4 o = (x1 - sr.x) * sr.y; u32x2v w; w.x = cvt_pk_bf16(o[0], o[1]); w.y = cvt_pk_bf16(o[2], o[3]);
                        if (bad) { w.x = 0x7fc07fc0u; w.y = 0x7fc07fc0u; } *(u32x2v*)(xn + off + bj * HALF + n * 16) = w; }
                asm volatile("" ::: "memory"); }
    }
};

template <class Epi, class Sched, bool ALIGN_EPI = false, bool SP2 = false>
__device__ __forceinline__ void gemm_phase(PG8_LAS unsigned char* lds, const Gemm g, const Sched& S, const Epi& E) {
    int tid_ = threadIdx.x; asm volatile("" : "+v"(tid_));
    const int tid = tid_, wid = __builtin_amdgcn_readfirstlane(tid >> 6), lane = tid & 63, wr = wid >> 2, wc = wid & 3, fr = lane & 15, fq = lane >> 4;
    const int K = g.K, nt = K / BK;
    unsigned voffA[2], voffB[2];
#pragma unroll
    for (int i = 0; i < 2; ++i) { int R, C; stage_rc(tid * 16 + i * 8192, R, C); const int Rb = Epi::PERM ? ((R & ~31) + perm32(R & 31)) : R;
        voffA[i] = (unsigned)(R * K + C) * 2u; voffB[i] = (unsigned)(Rb * K + C) * 2u; }
    const size_t kstep = (size_t)(BK * 2);
    const size_t hstep = (size_t)HALF * K * 2;
    const size_t tstep = 2 * hstep;
    const unsigned ldsw = (unsigned)wid * 1024u;
    const int aoff = lds_byte(wr * 64 + fr, fq * 8), boff = lds_byte(wc * 32 + fr, fq * 8);
#define PG8_SA(b, h) (((b) * 2 + (h)) * HTB)
#define PG8_SB(b, h) ((4 + (b) * 2 + (h)) * HTB)
#define PG8_STAGE(bufoff, gbase, voff) do { _Pragma("unroll") for (int _i = 0; _i < 2; ++_i) \
        __builtin_amdgcn_global_load_lds((const unsigned*)((const char*)(gbase) + (voff)[_i]), (PG8_LAS unsigned*)(lds + (bufoff) + ldsw + _i * 8192), 16, 0, 0); } while (0)
#define PG8_LDA(dst, b, h) do { _Pragma("unroll") for (int m = 0; m < 4; ++m) _Pragma("unroll") for (int k = 0; k < 2; ++k) dst[m][k] = *(const PG8_LAS bf16x8*)(lds + PG8_SA(b, h) + aoff + m * 2048 + k * 1024); } while (0)
#define PG8_LDB(dst, b, h) do { _Pragma("unroll") for (int n = 0; n < 2; ++n) _Pragma("unroll") for (int k = 0; k < 2; ++k) dst[n][k] = *(const PG8_LAS bf16x8*)(lds + PG8_SB(b, h) + boff + n * 2048 + k * 1024); } while (0)
#define PG8_MMA(ai, bj, At, Bt) do { __builtin_amdgcn_s_setprio(1); _Pragma("unroll") for (int m = 0; m < 4; ++m) _Pragma("unroll") for (int n = 0; n < 2; ++n) _Pragma("unroll") for (int k = 0; k < 2; ++k) \
        acc[ai][bj][m][n] = __builtin_amdgcn_mfma_f32_16x16x32_bf16(Bt[n][k], At[m][k], acc[ai][bj][m][n], 0, 0, 0); __builtin_amdgcn_s_setprio(0); } while (0)
#define PG8_WAIT_V(n) asm volatile("s_waitcnt vmcnt(" #n ")" ::: "memory")
#define PG8_WAIT_L(n) asm volatile("s_waitcnt lgkmcnt(" #n ")" ::: "memory")
#define PG8_BAR __builtin_amdgcn_s_barrier()
#define PG8_SCHED __builtin_amdgcn_sched_barrier(0)
    Unit cur, nxt; int ui = 0;
    if (!S.next(0, cur)) return;
    f32x4 acc[2][2][4][2];
#pragma unroll
    for (int a = 0; a < 2; ++a)
#pragma unroll
        for (int b = 0; b < 2; ++b)
#pragma unroll
            for (int m = 0; m < 4; ++m)
#pragma unroll
                for (int n = 0; n < 2; ++n) acc[a][b][m][n] = (f32x4){0.f, 0.f, 0.f, 0.f};
    bf16x8 At[4][2], B0[2][2], B1[2][2];
    const char* cA = (const char*)g.A + (size_t)cur.pm * tstep; const char* cB = (const char*)g.Bt + (size_t)cur.pn * tstep;
    S.a_ready(cur);
    if constexpr (SP2) {
        PG8_STAGE(PG8_SB(0, 0), cB, voffB); PG8_STAGE(PG8_SB(0, 1), cB + hstep, voffB); PG8_STAGE(PG8_SA(0, 0), cA, voffA); PG8_STAGE(PG8_SA(0, 1), cA + hstep, voffA);
        if (wr == 1) PG8_BAR;
        PG8_WAIT_V(2); PG8_BAR;
        PG8_STAGE(PG8_SB(1, 0), cB + kstep, voffB); PG8_STAGE(PG8_SA(1, 0), cA + kstep, voffA); PG8_STAGE(PG8_SB(1, 1), cB + hstep + kstep, voffB);
        PG8_WAIT_V(6); PG8_BAR;
    } else {
        PG8_STAGE(PG8_SB(0, 0), cB, voffB); PG8_STAGE(PG8_SA(0, 0), cA, voffA); PG8_STAGE(PG8_SB(0, 1), cB + hstep, voffB); PG8_STAGE(PG8_SA(0, 1), cA + hstep, voffA);
        if (wr == 1) PG8_BAR;
        PG8_WAIT_V(4); PG8_BAR;
        PG8_STAGE(PG8_SB(1, 0), cB + kstep, voffB); PG8_STAGE(PG8_SA(1, 0), cA + kstep, voffA); PG8_STAGE(PG8_SB(1, 1), cB + hstep + kstep, voffB);
        PG8_WAIT_V(6); PG8_BAR;
    }
    for (;;) {
        const bool has_next = S.next(ui + 1, nxt);
        const char* nA = has_next ? (const char*)g.A + (size_t)nxt.pm * tstep : cA; const char* nB = has_next ? (const char*)g.Bt + (size_t)nxt.pn * tstep : cB;
        for (int t = 0; t < nt; t += 2) {
            const bool last = (t == nt - 2);
            const char* a1 = cA + (size_t)(t + 1) * kstep;
            const char* a2 = last ? nA : cA + (size_t)(t + 2) * kstep; const char* b2 = last ? nB : cB + (size_t)(t + 2) * kstep;
            const char* a3 = a2 + kstep; const char* b3 = b2 + kstep;
            if (last && has_next) S.a_ready(nxt);
            if constexpr (SP2) {
            PG8_LDB(B0, 0, 0); PG8_LDB(B1, 0, 1); PG8_SCHED; PG8_LDA(At, 0, 0); PG8_STAGE(PG8_SA(1, 1), a1 + hstep, voffA);
            PG8_WAIT_V(8); PG8_WAIT_L(0); PG8_BAR; PG8_MMA(0, 0, At, B0); PG8_MMA(0, 1, At, B1); PG8_BAR; PG8_SCHED;
            PG8_LDA(At, 0, 1); PG8_STAGE(PG8_SB(0, 0), b2, voffB); PG8_STAGE(PG8_SB(0, 1), b2 + hstep, voffB); PG8_STAGE(PG8_SA(0, 0), a2, voffA);
            PG8_WAIT_V(8); PG8_WAIT_L(0); PG8_BAR; PG8_MMA(1, 0, At, B0); PG8_MMA(1, 1, At, B1); PG8_BAR; PG8_SCHED;
            PG8_LDB(B0, 1, 0); PG8_LDB(B1, 1, 1); PG8_SCHED; PG8_LDA(At, 1, 0); PG8_STAGE(PG8_SA(0, 1), a2 + hstep, voffA);
            PG8_WAIT_V(8); PG8_WAIT_L(0); PG8_BAR; PG8_MMA(0, 0, At, B0); PG8_MMA(0, 1, At, B1); PG8_BAR; PG8_SCHED;
            PG8_LDA(At, 1, 1); PG8_STAGE(PG8_SB(1, 0), b3, voffB); PG8_STAGE(PG8_SB(1, 1), b3 + hstep, voffB); PG8_STAGE(PG8_SA(1, 0), a3, voffA);
            PG8_WAIT_V(8); PG8_WAIT_L(0); PG8_BAR; PG8_MMA(1, 0, At, B0); PG8_MMA(1, 1, At, B1); PG8_BAR; PG8_SCHED;
            } else {
            PG8_LDB(B0, 0, 0); PG8_SCHED; PG8_LDA(At, 0, 0); PG8_STAGE(PG8_SA(1, 1), a1 + hstep, voffA);
            PG8_WAIT_L(8); PG8_BAR; PG8_WAIT_L(0); PG8_MMA(0, 0, At, B0); PG8_BAR; PG8_SCHED;
            PG8_LDB(B1, 0, 1); PG8_STAGE(PG8_SB(0, 0), b2, voffB);
            PG8_BAR; PG8_WAIT_L(0); PG8_MMA(0, 1, At, B1); PG8_BAR;
            PG8_LDA(At, 0, 1); PG8_STAGE(PG8_SA(0, 0), a2, voffA);
            PG8_BAR; PG8_WAIT_L(0); PG8_MMA(1, 0, At, B0); PG8_BAR; PG8_SCHED;
            PG8_STAGE(PG8_SB(0, 1), b2 + hstep, voffB);
            PG8_WAIT_V(6); PG8_BAR; PG8_MMA(1, 1, At, B1); PG8_BAR;
            PG8_LDB(B0, 1, 0); PG8_SCHED; PG8_LDA(At, 1, 0); PG8_STAGE(PG8_SA(0, 1), a2 + hstep, voffA);
            PG8_WAIT_L(8); PG8_BAR; PG8_WAIT_L(0); PG8_MMA(0, 0, At, B0); PG8_BAR; PG8_SCHED;
            PG8_LDB(B1, 1, 1); PG8_STAGE(PG8_SB(1, 0), b3, voffB);
            PG8_BAR; PG8_WAIT_L(0); PG8_MMA(0, 1, At, B1); PG8_BAR;
            PG8_LDA(At, 1, 1); PG8_STAGE(PG8_SA(1, 0), a3, voffA);
            PG8_BAR; PG8_WAIT_L(0); PG8_MMA(1, 0, At, B0); PG8_BAR; PG8_SCHED;
            PG8_STAGE(PG8_SB(1, 1), b3 + hstep, voffB);
            PG8_WAIT_V(6); PG8_BAR; PG8_MMA(1, 1, At, B1); PG8_BAR;
            }
        }
        if constexpr (ALIGN_EPI) { if (wr == 0) PG8_BAR; }
        if constexpr (!Epi::AFTER_DRAIN) { E(acc, cur, wr, wc, fr, fq); S.done(cur); }
        if (!has_next) break;
#pragma unroll
        for (int a = 0; a < 2; ++a)
#pragma unroll
            for (int b = 0; b < 2; ++b)
#pragma unroll
                for (int m = 0; m < 4; ++m)
#pragma unroll
                    for (int n = 0; n < 2; ++n) acc[a][b][m][n] = (f32x4){0.f, 0.f, 0.f, 0.f};
        cur = nxt; cA = nA; cB = nB; ++ui;
        if constexpr (ALIGN_EPI) { if (wr == 1) PG8_BAR; }
    }
    PG8_WAIT_V(0);
    if constexpr (!ALIGN_EPI) { if (wr == 0) PG8_BAR; }
    PG8_BAR;
    if constexpr (Epi::AFTER_DRAIN) { E.fused(acc, cur, wr, wc, fr, fq, lds, wid, lane); S.done(cur); }
#undef PG8_SA
#undef PG8_SB
#undef PG8_STAGE
#undef PG8_LDA
#undef PG8_LDB
#undef PG8_MMA
#undef PG8_WAIT_V
#undef PG8_WAIT_L
#undef PG8_BAR
#undef PG8_SCHED
}
}

#include <hip/hip_cooperative_groups.h>
namespace cg = cooperative_groups;

#define GAS __attribute__((address_space(1)))
#define LAS __attribute__((address_space(3)))
typedef unsigned short bf16;
typedef unsigned v4u __attribute__((ext_vector_type(4)));
typedef unsigned v2u __attribute__((ext_vector_type(2)));
typedef unsigned u32x4w __attribute__((ext_vector_type(4)));
typedef float f32x4 __attribute__((ext_vector_type(4)));
typedef short bf16x8 __attribute__((ext_vector_type(8)));
#define LDS_WAIT() asm volatile("s_waitcnt lgkmcnt(0)" ::: "memory")

constexpr int BATCH = 2, SEQ = 16384, D = 1024, M = BATCH * SEQ, NIN = 3584, FF = 4096, DEPTH = 2;
constexpr int HW = 512;
constexpr float ALPHA = 1.4142135623730951f;
constexpr float LN_EPS = 1e-5f, RMS_EPS = 1e-6f;
constexpr size_t MiB = 1u << 20;
constexpr size_t WS_W = 0;
constexpr size_t W_LAYER = 25 * MiB, W_IN = 0, W_O = 7 * MiB, W_1 = 9 * MiB, W_2 = 17 * MiB;
constexpr size_t WS_XB = 52 * MiB;
constexpr size_t WS_A = 116 * MiB;
constexpr size_t SEG_BYTES = 32 * MiB;
constexpr size_t WS_LF = WS_A + 6 * SEG_BYTES;
constexpr size_t WS_B = 372 * MiB;
constexpr size_t WS_ORAW = WS_B + 64 * MiB;
constexpr size_t WS_ML = 500 * MiB;
constexpr size_t WS_DV = 506 * MiB;
constexpr size_t WS_BAR = 506 * MiB + 512 * 1024;
constexpr size_t WS_END = 507 * MiB;
constexpr int LDS_BYTES = 131072 + 2048;
constexpr int NWAVES = 8;

__device__ __forceinline__ unsigned f2bf(float f) { unsigned u = __builtin_bit_cast(unsigned, f); return (u + 0x7fffu + ((u >> 16) & 1u)) >> 16; }
__device__ __forceinline__ unsigned pk2(float lo, float hi) { return f2bf(lo) | (f2bf(hi) << 16); }
__device__ __forceinline__ float bf2f(unsigned short h) { return __builtin_bit_cast(float, (unsigned)h << 16); }
__device__ __forceinline__ float bflo(unsigned w) { return __builtin_bit_cast(float, w << 16); }
__device__ __forceinline__ float bfhi(unsigned w) { return __builtin_bit_cast(float, w & 0xffff0000u); }
__device__ __forceinline__ float wave_sum(float v) {
#pragma unroll
    for (int o = 1; o < 64; o <<= 1) v += __shfl_xor(v, o);
    return v;
}
__device__ __forceinline__ float wave_max(float v) {
#pragma unroll
    for (int o = 1; o < 64; o <<= 1) v = fmaxf(v, __shfl_xor(v, o));
    return v;
}

typedef GAS unsigned gu32;
#define XB_TMO      128
#define XB_XCNT(j)  (256  + 64 * (j))
#define XB_XSUB(j)  (1280 + 64 * (j))
#define XB_XGEN(j)  (2304 + 64 * (j))
#define XB_TOP      3328
#define XB_TOPGEN   3392
#define XCD_BAR_WORDS 3456
#define XB_SPIN_CAP (1u << 18)

__device__ __forceinline__ unsigned xb_ld(unsigned* p)              { return __hip_atomic_load(p, __ATOMIC_RELAXED, __HIP_MEMORY_SCOPE_AGENT); }
__device__ __forceinline__ unsigned xb_add(unsigned* p, unsigned v) { return __hip_atomic_fetch_add(p, v, __ATOMIC_RELAXED, __HIP_MEMORY_SCOPE_AGENT); }
__device__ __forceinline__ unsigned xb_xcc_id() { return (unsigned)__builtin_amdgcn_s_getreg((3 << 11) | 20) & 0xFu; }
#define XB_SPIN(cond, bar) do { unsigned _sp = 0; while (cond) { __builtin_amdgcn_s_sleep(1); \
    if ((++_sp & 255u) == 0u) { if (xb_ld(&(bar)[XB_TMO])) break; if (_sp > XB_SPIN_CAP) { atomicAdd(&(bar)[XB_TMO], 1u); break; } } } } while (0)

struct XcdBarrier {
    unsigned* bar; unsigned x;
    volatile LAS unsigned* st;
};

__device__ __forceinline__ XcdBarrier xcd_barrier_post(unsigned* bar, volatile LAS unsigned* st) {
    XcdBarrier b; b.bar = bar; b.x = xb_xcc_id(); b.st = st;
    if (threadIdx.x == 0) (void)xb_add(&bar[XB_XCNT(b.x)], 1u);
    return b;
}
__device__ __forceinline__ void xcd_barrier_complete(unsigned* bar, unsigned x, unsigned& nloc, unsigned& nx) {
    const unsigned G = gridDim.x * gridDim.y * gridDim.z;
    unsigned sum, cnt, mine, sp = 0u;
    for (;;) {
        sum = 0u; cnt = 0u; mine = 0u;
#pragma unroll
        for (unsigned j = 0; j < 16; ++j) { const unsigned c = xb_ld(&bar[XB_XCNT(j)]); sum += c; cnt += (c > 0u) ? 1u : 0u; mine = (j == x) ? c : mine; }
        if (sum == G) break;
        __builtin_amdgcn_s_sleep(1);
        if ((++sp & 255u) == 0u) { if (xb_ld(&bar[XB_TMO])) break; if (sp > XB_SPIN_CAP) { atomicAdd(&bar[XB_TMO], 1u); break; } }
    }
    nloc = mine > 0u ? mine : 1u; nx = cnt > 0u ? cnt : 1u;
}

__device__ __forceinline__ void xcd_barrier(const XcdBarrier& b) {
    asm volatile("s_waitcnt vmcnt(0)" ::: "memory");
    __syncthreads();
    if (threadIdx.x == 0) {
        unsigned* bar = b.bar;
        __builtin_amdgcn_s_waitcnt(0);
        unsigned nloc = b.st[0], nx = b.st[1];
        if (nloc == 0u) { xcd_barrier_complete(bar, b.x, nloc, nx); b.st[0] = nloc; b.st[1] = nx; }
        const unsigned old = xb_add(&bar[XB_XSUB(b.x)], 1u);
        const unsigned gen = old / nloc;
        if (old + 1u == (gen + 1u) * nloc) {
            __builtin_amdgcn_fence(__ATOMIC_RELEASE, "agent");
            asm volatile("s_waitcnt vmcnt(0)" ::: "memory");
            const unsigned og = xb_add(&bar[XB_TOP], 1u);
            const unsigned tg = og / nx;
            if (og + 1u == (tg + 1u) * nx) xb_add(&bar[XB_TOPGEN], 1u);
            else XB_SPIN(xb_ld(&bar[XB_TOPGEN]) == tg, bar);
            __builtin_amdgcn_fence(__ATOMIC_ACQUIRE, "agent");
            xb_add(&bar[XB_XGEN(b.x)], 1u);
            asm volatile("s_waitcnt vmcnt(0)" ::: "memory");
        } else {
            XB_SPIN(xb_ld(&bar[XB_XGEN(b.x)]) == gen, bar);
            __builtin_amdgcn_fence(__ATOMIC_ACQUIRE, "agent");
            asm volatile("s_waitcnt vmcnt(0)" ::: "memory");
        }
    }
    __syncthreads();
}

namespace pg8 {
struct EpiInProj {
    static constexpr bool PERM = true, AFTER_DRAIN = false;
    bf16_t* seg; float* lf; const float* lb0; const float* lb1; int layer;
    __device__ __forceinline__ void operator()(const f32x4 (&acc)[2][2][4][2], const Unit& u, int wr, int wc, int fr, int fq) const {
        const int t = u.pn >> 1;
        int row0 = u.pm * BM + wr * 64 + fr;
        int cs0 = (u.pn & 1) * 256 + wc * 32 + 8 * fq; asm volatile("" : "+v"(row0), "+v"(cs0));
        if (t == 1) {
#pragma unroll
            for (int bj = 0; bj < 2; ++bj) {
                float lbv[8];
#pragma unroll
                for (int i = 0; i < 8; ++i) { const int c = cs0 + bj * HALF + i; lbv[i] = layer ? 1.0f / (1.0f + __expf(-(lb1[c] - lb0[c]))) : 0.0f; }
#pragma unroll
                for (int ai = 0; ai < 2; ++ai)
#pragma unroll
                    for (int m = 0; m < 4; ++m) {
                        float* p = lf + (size_t)(row0 + ai * HALF + m * 16) * 512 + cs0 + bj * HALF;
                        f32x4 o[2];
#pragma unroll
                        for (int n = 0; n < 2; ++n)
#pragma unroll
                            for (int e = 0; e < 4; ++e) { const float z = acc[ai][bj][m][n][e]; const float sg = 1.0f / (1.0f + __expf(-z)); const float lb = lbv[n * 4 + e]; o[n][e] = __logf(lb + (1.0f - lb) * sg); }
                        *(f32x4*)p = o[0]; *(f32x4*)(p + 4) = o[1]; asm volatile("" ::: "memory");
                    }
            }
        } else {
            const int di = t == 0 ? 0 : t - 1;
            bf16_t* base = seg + (size_t)di * ((size_t)32 * 1024 * 1024 / 2);
#pragma unroll
            for (int ai = 0; ai < 2; ++ai)
#pragma unroll
                for (int m = 0; m < 4; ++m)
#pragma unroll
                    for (int bj = 0; bj < 2; ++bj) {
                        float v[8];
#pragma unroll
                        for (int n = 0; n < 2; ++n)
#pragma unroll
                            for (int e = 0; e < 4; ++e) { float z = acc[ai][bj][m][n][e];
                                if (t == 0) z = z / (1.0f + __expf(-z));
                                else if (t == 3) z = 1.0f / (1.0f + __expf(-z));
                                else if (t == 4) z = z * 0.18033688011112042f;
                                v[n * 4 + e] = z; }
                        u32x4 w; w.x = cvt_pk_bf16(v[0], v[1]); w.y = cvt_pk_bf16(v[2], v[3]); w.z = cvt_pk_bf16(v[4], v[5]); w.w = cvt_pk_bf16(v[6], v[7]);
                        *(u32x4*)(base + (size_t)(row0 + ai * HALF + m * 16) * 512 + cs0 + bj * HALF) = w;
                    }
        }
    }
};
struct EpiResid {
    static constexpr bool PERM = true, AFTER_DRAIN = false;
    const float* res; float* out; float alpha;
    __device__ __forceinline__ void operator()(const f32x4 (&acc)[2][2][4][2], const Unit& u, int wr, int wc, int fr, int fq) const {
        int row0 = u.pm * BM + wr * 64 + fr; int col0 = u.pn * BM + wc * 32 + 8 * fq; asm volatile("" : "+v"(row0), "+v"(col0));
#pragma unroll
        for (int ai = 0; ai < 2; ++ai)
#pragma unroll
            for (int m = 0; m < 4; ++m)
#pragma unroll
                for (int bj = 0; bj < 2; ++bj) {
                    const size_t off = (size_t)(row0 + ai * HALF + m * 16) * 1024 + col0 + bj * HALF;
                    const f32x4 r0 = *(const f32x4*)(res + off), r1 = *(const f32x4*)(res + off + 4);
                    *(f32x4*)(out + off) = r0 * alpha + acc[ai][bj][m][0]; *(f32x4*)(out + off + 4) = r1 * alpha + acc[ai][bj][m][1];
                    if (bj == 1) asm volatile("" ::: "memory");
                }
    }
};
struct EpiSqRelu {
    static constexpr bool PERM = true, AFTER_DRAIN = false;
    bf16_t* out;
    __device__ __forceinline__ void operator()(const f32x4 (&acc)[2][2][4][2], const Unit& u, int wr, int wc, int fr, int fq) const {
        int row0 = u.pm * BM + wr * 64 + fr; int col0 = u.pn * BM + wc * 32 + 8 * fq; asm volatile("" : "+v"(row0), "+v"(col0));
#pragma unroll
        for (int ai = 0; ai < 2; ++ai)
#pragma unroll
            for (int m = 0; m < 4; ++m)
#pragma unroll
                for (int bj = 0; bj < 2; ++bj) {
                    f32x4 a = acc[ai][bj][m][0], b = acc[ai][bj][m][1];
#pragma unroll
                    for (int e = 0; e < 4; ++e) { a[e] = fmaxf(a[e], 0.f); a[e] *= a[e]; b[e] = fmaxf(b[e], 0.f); b[e] *= b[e]; }
                    u32x4 w; w.x = cvt_pk_bf16(a[0], a[1]); w.y = cvt_pk_bf16(a[2], a[3]); w.z = cvt_pk_bf16(b[0], b[1]); w.w = cvt_pk_bf16(b[2], b[3]);
                    *(u32x4*)(out + (size_t)(row0 + ai * HALF + m * 16) * 4096 + col0 + bj * HALF) = w;
                }
    }
};
}

__device__ __forceinline__ void p0_transpose_item(const float* W, int K, int N, bf16* WT, LAS float* scr, int item, int lane) {
    asm volatile("" : "+v"(lane));
    const int nblk = N / 32, kb = item / nblk, nb = item % nblk, k0 = 64 * kb, n0 = 32 * nb;
#pragma unroll 8
    for (int i = 0; i < 32; ++i) { const int kk = 2 * i + (lane >> 5); scr[kk * 33 + (lane & 31)] = W[(size_t)(k0 + kk) * N + n0 + (lane & 31)]; }
    LDS_WAIT(); asm volatile("" ::: "memory");
    const int c = lane & 7;
#pragma unroll
    for (int j = 0; j < 4; ++j) { const int n = (lane >> 3) + 8 * j; const LAS float* s = scr + (8 * c) * 33 + n;
        v4u o; o.x = pk2(s[0 * 33], s[1 * 33]); o.y = pk2(s[2 * 33], s[3 * 33]); o.z = pk2(s[4 * 33], s[5 * 33]); o.w = pk2(s[6 * 33], s[7 * 33]);
        *(GAS v4u*)(WT + (size_t)(n0 + n) * K + k0 + 8 * c) = o; }
    LDS_WAIT(); asm volatile("" ::: "memory");
}

struct Args { const float* in[11]; float* out; unsigned char* ws; };

__device__ __forceinline__ void ln_rows(const float* src, float* dst, bf16* xb, const float* g, const float* b, int gw, int NGW, int lane) {
    asm volatile("" : "+v"(lane));
    f32x4 gv[4], bv[4];
#pragma unroll
    for (int j = 0; j < 4; ++j) { gv[j] = *((const f32x4*)g + lane + 64 * j); bv[j] = *((const f32x4*)b + lane + 64 * j); }
    for (int m = gw; m < M; m += NGW) {
        const f32x4* xr = (const f32x4*)(src + (size_t)m * D) + lane;
        f32x4 v[4]; float s = 0.f;
#pragma unroll
        for (int j = 0; j < 4; ++j) { v[j] = xr[64 * j]; s += (v[j].x + v[j].y) + (v[j].z + v[j].w); }
        const float mean = wave_sum(s) * (1.f / D); float s2 = 0.f;
#pragma unroll
        for (int j = 0; j < 4; ++j) { v[j] = v[j] - mean; s2 += (v[j].x * v[j].x + v[j].y * v[j].y) + (v[j].z * v[j].z + v[j].w * v[j].w); }
        const float rstd = 1.f / sqrtf(wave_sum(s2) * (1.f / D) + LN_EPS);
        f32x4* o4 = (f32x4*)(dst + (size_t)m * D) + lane;
        v2u* o8 = (v2u*)(xb + (size_t)m * D) + lane;
#pragma unroll
        for (int j = 0; j < 4; ++j) { const f32x4 y = v[j] * rstd * gv[j] + bv[j]; o4[64 * j] = y; v2u w; w.x = pk2(y.x, y.y); w.y = pk2(y.z, y.w); o8[64 * j] = w; }
    }
}

__device__ __forceinline__ void hgrn_simple(const bf16* QS, const float* LF, const bf16* VI, float* ORAW, int gw, int lane) {
    asm volatile("" : "+v"(lane));
    if (gw >= BATCH * 4 * 128) return;
    const int b = gw >> 9, h = (gw >> 7) & 3, v = gw & 127;
    float S0 = 0.f, S1 = 0.f;
    const size_t rb = (size_t)b * SEQ;
    for (int t0 = 0; t0 < SEQ; t0 += 16) {
        float lf0[16], lf1[16], q0[16], q1[16], vv[16];
#pragma unroll
        for (int i = 0; i < 16; ++i) { const size_t o = (rb + t0 + i) * 512 + h * 128;
            lf0[i] = LF[o + lane]; lf1[i] = LF[o + 64 + lane]; q0[i] = bf2f(QS[o + lane]); q1[i] = bf2f(QS[o + 64 + lane]); vv[i] = bf2f(VI[o + v]); }
        float res = 0.f;
#pragma unroll
        for (int i = 0; i < 16; ++i) {
            const float f0 = __expf(lf0[i]), f1 = __expf(lf1[i]);
            S0 = f0 * S0 + (1.f - f0) * vv[i]; S1 = f1 * S1 + (1.f - f1) * vv[i];
            const float p = wave_sum(q0[i] * S0 + q1[i] * S1);
            if (lane == i) res = p;
        }
        if (lane < 16) ORAW[(rb + t0 + lane) * 512 + h * 128 + v] = res;
    }
}
__device__ __forceinline__ void hgrn_finalize(const float* ORAW, const bf16* GT, const float* nw, bf16* O, int gw, int NGW, int lane) {
    asm volatile("" : "+v"(lane));
    for (int it = gw; it < M * 4; it += NGW) {
        const int row = it >> 2, h = it & 3; const size_t o = (size_t)row * 512 + h * 128 + 2 * lane;
        const float a = ORAW[o], c = ORAW[o + 1];
        const float ss = wave_sum(a * a + c * c);
        const float r = 1.0f / sqrtf(ss * (1.f / 128.f) + RMS_EPS);
        const unsigned gt = *(const unsigned*)(GT + o);
        const float y0 = a * r * nw[h * 128 + 2 * lane] * bflo(gt), y1 = c * r * nw[h * 128 + 2 * lane + 1] * bfhi(gt);
        *(unsigned*)(O + (size_t)row * D + h * 128 + 2 * lane) = pk2(y0, y1);
    }
}
__device__ __forceinline__ float dot8(v4u a, v4u b) {
    return bflo(a.x) * bflo(b.x) + bfhi(a.x) * bfhi(b.x) + bflo(a.y) * bflo(b.y) + bfhi(a.y) * bfhi(b.y) + bflo(a.z) * bflo(b.z) + bfhi(a.z) * bfhi(b.z) + bflo(a.w) * bflo(b.w) + bfhi(a.w) * bfhi(b.w);
}
__device__ __forceinline__ void attn_simple(const bf16* AQ, const bf16* AK, const bf16* AV, bf16* O, LAS float* pbuf, int gw, int NGW, int lane) {
    asm volatile("" : "+v"(lane));
    for (int it = gw; it < M * 8; it += NGW) {
        const int row = it >> 3, h = it & 7, b = row / SEQ, t = row % SEQ;
        const v4u* qp = (const v4u*)(AQ + (size_t)row * 512 + h * 64);
        v4u q[8];
#pragma unroll
        for (int i = 0; i < 8; ++i) q[i] = qp[i];
        float sc[6]; float mx = -INFINITY;
#pragma unroll
        for (int p = 0; p < 3; ++p) { const int d = p == 0 ? 1 : (p == 1 ? 4 : 16);
#pragma unroll
            for (int c = 0; c < 2; ++c) { const int j = 1 + 64 * c + lane; const int s = t - j * d; float a = -INFINITY;
                if (s >= 0) { const v4u* kp = (const v4u*)(AK + ((size_t)b * SEQ + s) * 512 + h * 64); a = 0.f;
#pragma unroll
                    for (int i = 0; i < 8; ++i) a += dot8(q[i], kp[i]); }
                sc[p * 2 + c] = a; mx = fmaxf(mx, a); } }
        float sself = 0.f; { const v4u* kp = (const v4u*)(AK + (size_t)row * 512 + h * 64);
#pragma unroll
            for (int i = 0; i < 8; ++i) sself += dot8(q[i], kp[i]); }
        mx = fmaxf(wave_max(mx), sself);
        float l = 0.f;
#pragma unroll
        for (int i = 0; i < 6; ++i) { const float e = __expf(sc[i] - mx); pbuf[i * 64 + lane] = e; l += e; }
        const float pself = 3.0f * __expf(sself - mx);
        l = wave_sum(l) + pself;
        LDS_WAIT(); asm volatile("" ::: "memory");
        float o = pself * bf2f(AV[(size_t)row * 512 + h * 64 + lane]);
#pragma unroll
        for (int p = 0; p < 3; ++p) { const int d = p == 0 ? 1 : (p == 1 ? 4 : 16);
            int jmax = t / d; if (jmax > 128) jmax = 128;
#pragma unroll 8
            for (int j = 1; j <= jmax; ++j) o += pbuf[p * 128 + j - 1] * bf2f(AV[((size_t)b * SEQ + t - j * d) * 512 + h * 64 + lane]);
        }
        O[(size_t)row * D + 512 + h * 64 + lane] = (bf16)f2bf(o / l);
        LDS_WAIT(); asm volatile("" ::: "memory");
    }
}

typedef float f32x16 __attribute__((ext_vector_type(16)));
typedef short v4i16_t __attribute__((ext_vector_type(4)));
constexpr int IMG_STRIDE = 16384 + 64, VHALF_BYTES = 2 * IMG_STRIDE;
__device__ __forceinline__ int crow(int r, int hi) { return (r & 3) + 8 * (r >> 2) + 4 * hi; }
__device__ __forceinline__ void attn_mfma(const bf16* AQ, const bf16* AK, const bf16* AV, bf16* O, bf16* XBp, float* ML, LAS unsigned char* L, int tid) {
    asm volatile("" : "+v"(tid));
    const int lane = tid & 63, wave = __builtin_amdgcn_readfirstlane(tid >> 6), half = wave >> 2, qi = wave & 3, l31 = lane & 31, hi = lane >> 5, ti = tid & 255;
    LAS unsigned char* Vimg = L + half * VHALF_BYTES;
    const int G = gridDim.x;
    for (int pair = blockIdx.x; pair < 3072; pair += G) {
        const int it = pair * 2 + half;
        const int bh = it / 384, rem = it - bh * 384, p = rem >> 7, c = rem & 127, sh = 2 * p, dil = 1 << sh, r = c & (dil - 1), n = c >> sh;
        const int b = bh >> 3, h = bh & 7;
        const size_t rowbase = (size_t)b * SEQ;
        __syncthreads();
#pragma unroll
        for (int k = 0; k < 8; ++k) {
            const int cid = ti + 256 * k, j = cid >> 3, cc = cid & 7; int m = 128 * (n - 1) + j; m = m < 0 ? 0 : m;
            const v4u v = *(const v4u*)(AV + (rowbase + (size_t)(m * dil + r)) * 512 + h * 64 + 8 * cc);
            *(LAS v4u*)(Vimg + (cc >> 2) * IMG_STRIDE + j * 64 + (cc & 3) * 16) = v;
        }
        const size_t qrow = rowbase + (size_t)((128 * n + 32 * qi + l31) * dil + r);
        bf16x8 qf[4];
        { const bf16x8* qp = (const bf16x8*)(AQ + qrow * 512 + h * 64 + 32 * hi);
#pragma unroll
          for (int ks = 0; ks < 4; ++ks) qf[ks] = qp[ks]; }
        f32x16 S[5];
#pragma unroll
        for (int kk = 0; kk < 5; ++kk) {
            int m = 128 * (n - 1) + 32 * (qi + kk) + l31; m = m < 0 ? 0 : m;
            const bf16x8* kp = (const bf16x8*)(AK + (rowbase + (size_t)(m * dil + r)) * 512 + h * 64 + 32 * hi);
            bf16x8 kf[4];
#pragma unroll
            for (int ks = 0; ks < 4; ++ks) kf[ks] = kp[ks];
            f32x16 a = {};
#pragma unroll
            for (int ks = 0; ks < 4; ++ks) a = __builtin_amdgcn_mfma_f32_32x32x16_bf16(kf[ks], qf[ks], a, 0, 0, 0);
            S[kk] = a;
        }
        float mx = -INFINITY;
#pragma unroll
        for (int kk = 0; kk < 5; ++kk)
#pragma unroll
            for (int jj = 0; jj < 16; ++jj) { const int kl = crow(jj, hi), jrel = 32 * kk + kl - l31;
                const bool valid = jrel >= 0 && jrel <= 128 && (n > 0 || 32 * (qi + kk) + kl >= 128);
                const float sv = valid ? S[kk][jj] : -INFINITY; S[kk][jj] = sv; mx = fmaxf(mx, sv); }
        mx = fmaxf(mx, __shfl_xor(mx, 32));
        float lsum = 0.f;
#pragma unroll
        for (int kk = 0; kk < 5; ++kk)
#pragma unroll
            for (int jj = 0; jj < 16; ++jj) { const float e = __builtin_amdgcn_exp2f(S[kk][jj] - mx); S[kk][jj] = e; lsum += e; }
        lsum += __shfl_xor(lsum, 32);
        __syncthreads();
        f32x16 o0 = {}, o1 = {};
        const int g = lane >> 4, q4 = (lane & 15) >> 2, p4 = lane & 3;
        const LAS unsigned char* vb = Vimg + (4 * (g >> 1) + q4) * 64 + (16 * (g & 1) + 4 * p4) * 2;
#pragma unroll
        for (int kk = 0; kk < 5; ++kk)
#pragma unroll
            for (int s2 = 0; s2 < 2; ++s2) {
                u32x4w pw; pw.x = pk2(S[kk][8 * s2 + 0], S[kk][8 * s2 + 1]); pw.y = pk2(S[kk][8 * s2 + 2], S[kk][8 * s2 + 3]); pw.z = pk2(S[kk][8 * s2 + 4], S[kk][8 * s2 + 5]); pw.w = pk2(S[kk][8 * s2 + 6], S[kk][8 * s2 + 7]);
                const bf16x8 pf = __builtin_bit_cast(bf16x8, pw);
                const LAS unsigned char* vk = vb + (32 * (qi + kk) + 16 * s2) * 64;
                const v4i16_t a00 = __builtin_amdgcn_ds_read_tr16_b64_v4i16((LAS v4i16_t*)(vk)), a01 = __builtin_amdgcn_ds_read_tr16_b64_v4i16((LAS v4i16_t*)(vk + 8 * 64));
                const v4i16_t a10 = __builtin_amdgcn_ds_read_tr16_b64_v4i16((LAS v4i16_t*)(vk + IMG_STRIDE)), a11 = __builtin_amdgcn_ds_read_tr16_b64_v4i16((LAS v4i16_t*)(vk + IMG_STRIDE + 8 * 64));
                const bf16x8 v0 = {a00[0], a00[1], a00[2], a00[3], a01[0], a01[1], a01[2], a01[3]}, v1 = {a10[0], a10[1], a10[2], a10[3], a11[0], a11[1], a11[2], a11[3]};
                o0 = __builtin_amdgcn_mfma_f32_32x32x16_bf16(v0, pf, o0, 0, 0, 0);
                o1 = __builtin_amdgcn_mfma_f32_32x32x16_bf16(v1, pf, o1, 0, 0, 0);
            }
        bf16* ob = p == 0 ? O + qrow * 1024 + 512 + h * 64 : XBp + (size_t)(p - 1) * ((size_t)M * 512) + qrow * 512 + h * 64;
#pragma unroll
        for (int g4 = 0; g4 < 4; ++g4) {
            v2u w0; w0.x = pk2(o0[4 * g4], o0[4 * g4 + 1]); w0.y = pk2(o0[4 * g4 + 2], o0[4 * g4 + 3]); *(v2u*)(ob + 8 * g4 + 4 * hi) = w0;
            v2u w1; w1.x = pk2(o1[4 * g4], o1[4 * g4 + 1]); w1.y = pk2(o1[4 * g4 + 2], o1[4 * g4 + 3]); *(v2u*)(ob + 32 + 8 * g4 + 4 * hi) = w1;
        }
        if (hi == 0) { float* mlp = ML + (((size_t)p * M + qrow) * 8 + h) * 2; mlp[0] = mx; mlp[1] = lsum; }
    }
}
__device__ __forceinline__ void attn_merge(bf16* O, const bf16* XBp, const float* ML, int gw, int NGW, int lane) {
    asm volatile("" : "+v"(lane));
    const int hh = lane >> 3, c8 = lane & 7;
    for (int row = gw; row < M; row += NGW) {
        float m[3], l[3];
#pragma unroll
        for (int p = 0; p < 3; ++p) { const float* mlp = ML + (((size_t)p * M + row) * 8 + hh) * 2; m[p] = mlp[0]; l[p] = mlp[1]; }
        const float ma = fmaxf(m[0], fmaxf(m[1], m[2]));
        float w[3], den = 0.f;
#pragma unroll
        for (int p = 0; p < 3; ++p) { w[p] = __builtin_amdgcn_exp2f(m[p] - ma); den += w[p] * l[p]; }
        const float inv = 1.0f / den;
        bf16* op = O + (size_t)row * 1024 + 512 + hh * 64 + 8 * c8;
        const v4u a = *(const v4u*)op, b1 = *(const v4u*)(XBp + (size_t)row * 512 + hh * 64 + 8 * c8), b2 = *(const v4u*)(XBp + (size_t)M * 512 + (size_t)row * 512 + hh * 64 + 8 * c8);
        v4u r;
        r.x = pk2((w[0] * bflo(a.x) + w[1] * bflo(b1.x) + w[2] * bflo(b2.x)) * inv, (w[0] * bfhi(a.x) + w[1] * bfhi(b1.x) + w[2] * bfhi(b2.x)) * inv);
        r.y = pk2((w[0] * bflo(a.y) + w[1] * bflo(b1.y) + w[2] * bflo(b2.y)) * inv, (w[0] * bfhi(a.y) + w[1] * bfhi(b1.y) + w[2] * bfhi(b2.y)) * inv);
        r.z = pk2((w[0] * bflo(a.z) + w[1] * bflo(b1.z) + w[2] * bflo(b2.z)) * inv, (w[0] * bfhi(a.z) + w[1] * bfhi(b1.z) + w[2] * bfhi(b2.z)) * inv);
        r.w = pk2((w[0] * bflo(a.w) + w[1] * bflo(b1.w) + w[2] * bflo(b2.w)) * inv, (w[0] * bfhi(a.w) + w[1] * bfhi(b1.w) + w[2] * bfhi(b2.w)) * inv);
        *(v4u*)op = r;
    }
}

constexpr int RS_T = 144, RS_C = 272;
constexpr int OFF_KD = 0, OFF_VT = 18432, OFF_QI = 36864, OFF_QM = 54272, OFF_KM = 71680, OFF_ST = 89088, OFF_PART = 123904, OFF_DVEC = 125952, OFF_SSQ = 126464;
template <int MODE>
__device__ __forceinline__ void hgrn_pass(const bf16* QS, const float* LF, const bf16* VI, const bf16* GT, const float* nw, float* STATE, float* DV, bf16* O, LAS unsigned char* L, int tid) {
    asm volatile("" : "+v"(tid));
    const int lane = tid & 63, wave = __builtin_amdgcn_readfirstlane(tid >> 6), l31 = lane & 31, hi = lane >> 5;
    const int c = tid & 127, tq = tid >> 7;
    const int vt = wave & 3, tt = wave >> 2, kt0 = 2 * (wave >> 2);
    LAS float* part = (LAS float*)(L + OFF_PART); LAS float* dvec = (LAS float*)(L + OFF_DVEC); LAS float* ssq = (LAS float*)(L + OFF_SSQ);
    for (int item = blockIdx.x; item < 512; item += gridDim.x) {
        const int bh = item >> 6, sc = item & 63, b = bh >> 2, h = bh & 3;
        const size_t row0 = (size_t)b * SEQ + sc * 256;
        f32x16 acc[2];
        if (MODE == 0) { acc[0] = (f32x16){}; acc[1] = (f32x16){}; }
        else {
#pragma unroll
            for (int kt2 = 0; kt2 < 2; ++kt2)
#pragma unroll
                for (int g4 = 0; g4 < 4; ++g4) {
                    const int v = 32 * vt + l31, k0 = 32 * (kt0 + kt2) + 8 * g4 + 4 * hi;
                    const f32x4 sv = *(const f32x4*)(STATE + (size_t)item * 16384 + v * 128 + k0);
                    acc[kt2][4 * g4 + 0] = sv[0]; acc[kt2][4 * g4 + 1] = sv[1]; acc[kt2][4 * g4 + 2] = sv[2]; acc[kt2][4 * g4 + 3] = sv[3];
                    v2u w; w.x = pk2(sv[0], sv[1]); w.y = pk2(sv[2], sv[3]);
                    *(LAS v2u*)(L + OFF_ST + v * RS_C + k0 * 2) = w;
                }
        }
        float gtot = 0.f;
        for (int ch = 0; ch < 4; ++ch) {
            const size_t rowc = row0 + ch * 64 + 16 * tq;
            float g[16], lfv[16]; unsigned short vv[16], qq[16];
            { const float* lfp = LF + rowc * 512 + h * 128 + c; const bf16* vp = VI + rowc * 512 + h * 128 + c; const bf16* qp = QS + rowc * 512 + h * 128 + c;
#pragma unroll
              for (int i = 0; i < 16; ++i) { lfv[i] = lfp[(size_t)i * 512]; vv[i] = vp[(size_t)i * 512]; if (MODE == 1) qq[i] = qp[(size_t)i * 512]; } }
            float run = 0.f;
#pragma unroll
            for (int i = 0; i < 16; ++i) { run += lfv[i]; g[i] = run; }
            part[tq * 128 + c] = run;
            { v4u w0, w1;
              w0.x = vv[0] | ((unsigned)vv[1] << 16); w0.y = vv[2] | ((unsigned)vv[3] << 16); w0.z = vv[4] | ((unsigned)vv[5] << 16); w0.w = vv[6] | ((unsigned)vv[7] << 16);
              w1.x = vv[8] | ((unsigned)vv[9] << 16); w1.y = vv[10] | ((unsigned)vv[11] << 16); w1.z = vv[12] | ((unsigned)vv[13] << 16); w1.w = vv[14] | ((unsigned)vv[15] << 16);
              *(LAS v4u*)(L + OFF_VT + c * RS_T + tq * 32) = w0; *(LAS v4u*)(L + OFF_VT + c * RS_T + tq * 32 + 16) = w1; }
            __syncthreads();
            const float p0 = part[c], p1 = part[128 + c], p2 = part[256 + c], p3 = part[384 + c];
            const float off = (tq > 0 ? p0 : 0.f) + (tq > 1 ? p1 : 0.f) + (tq > 2 ? p2 : 0.f);
            const float glast = (p0 + p1) + (p2 + p3), gmid = p0 + p1;
            if (tq == 0) { dvec[c] = __expf(glast); gtot += glast; }
            const float eLM = __expf(glast - gmid), emid = __expf(-gmid);
            unsigned kdw[8];
#pragma unroll
            for (int i = 0; i < 16; ++i) {
                const float G = off + g[i], f = __expf(lfv[i]), kk = 1.0f - f, km = kk * __expf(gmid - G), kd = km * eLM;
                if (i & 1) kdw[i >> 1] |= f2bf(kd) << 16; else kdw[i >> 1] = f2bf(kd);
                if (MODE == 1) {
                    const float qi = bf2f(qq[i]) * __expf(G), qm = qi * emid; const int t = 16 * tq + i;
                    *(LAS unsigned short*)(L + OFF_QI + t * RS_C + c * 2) = (unsigned short)f2bf(qi);
                    *(LAS unsigned short*)(L + OFF_QM + t * RS_C + c * 2) = (unsigned short)f2bf(qm);
                    *(LAS unsigned short*)(L + OFF_KM + t * RS_C + c * 2) = (unsigned short)f2bf(km);
                }
            }
            { v4u w0, w1; w0.x = kdw[0]; w0.y = kdw[1]; w0.z = kdw[2]; w0.w = kdw[3]; w1.x = kdw[4]; w1.y = kdw[5]; w1.z = kdw[6]; w1.w = kdw[7];
              *(LAS v4u*)(L + OFF_KD + c * RS_T + tq * 32) = w0; *(LAS v4u*)(L + OFF_KD + c * RS_T + tq * 32 + 16) = w1; }
            __syncthreads();
            if (MODE == 1) {
                f32x16 Pd = (f32x16){}, P0 = (f32x16){};
#pragma unroll
                for (int ks = 0; ks < 8; ++ks) {
                    const bf16x8 bq = *(const LAS bf16x8*)(L + OFF_QM + (32 * tt + l31) * RS_C + (16 * ks + 8 * hi) * 2);
                    const bf16x8 ad = *(const LAS bf16x8*)(L + OFF_KM + (32 * tt + l31) * RS_C + (16 * ks + 8 * hi) * 2);
                    Pd = __builtin_amdgcn_mfma_f32_32x32x16_bf16(ad, bq, Pd, 0, 0, 0);
                    if (tt == 1) { const bf16x8 a0 = *(const LAS bf16x8*)(L + OFF_KM + l31 * RS_C + (16 * ks + 8 * hi) * 2); P0 = __builtin_amdgcn_mfma_f32_32x32x16_bf16(a0, bq, P0, 0, 0, 0); }
                }
#pragma unroll
                for (int jj = 0; jj < 16; ++jj) if (crow(jj, hi) > l31) Pd[jj] = 0.f;
                f32x16 oT = (f32x16){};
#pragma unroll
                for (int ks = 0; ks < 8; ++ks) {
                    const bf16x8 as = *(const LAS bf16x8*)(L + OFF_ST + (32 * vt + l31) * RS_C + (16 * ks + 8 * hi) * 2);
                    const bf16x8 bq = *(const LAS bf16x8*)(L + OFF_QI + (32 * tt + l31) * RS_C + (16 * ks + 8 * hi) * 2);
                    oT = __builtin_amdgcn_mfma_f32_32x32x16_bf16(as, bq, oT, 0, 0, 0);
                }
#pragma unroll
                for (int s2 = 0; s2 < 2; ++s2) {
                    u32x4w pw; pw.x = pk2(Pd[8 * s2 + 0], Pd[8 * s2 + 1]); pw.y = pk2(Pd[8 * s2 + 2], Pd[8 * s2 + 3]); pw.z = pk2(Pd[8 * s2 + 4], Pd[8 * s2 + 5]); pw.w = pk2(Pd[8 * s2 + 6], Pd[8 * s2 + 7]);
                    const LAS unsigned char* vp = L + OFF_VT + (32 * vt + l31) * RS_T + (32 * tt + 16 * s2 + 4 * hi) * 2;
                    const v2u x0 = *(const LAS v2u*)vp, x1 = *(const LAS v2u*)(vp + 16);
                    u32x4w aw; aw.x = x0.x; aw.y = x0.y; aw.z = x1.x; aw.w = x1.y;
                    oT = __builtin_amdgcn_mfma_f32_32x32x16_bf16(__builtin_bit_cast(bf16x8, aw), __builtin_bit_cast(bf16x8, pw), oT, 0, 0, 0);
                }
                if (tt == 1) {
#pragma unroll
                    for (int s2 = 0; s2 < 2; ++s2) {
                        u32x4w pw; pw.x = pk2(P0[8 * s2 + 0], P0[8 * s2 + 1]); pw.y = pk2(P0[8 * s2 + 2], P0[8 * s2 + 3]); pw.z = pk2(P0[8 * s2 + 4], P0[8 * s2 + 5]); pw.w = pk2(P0[8 * s2 + 6], P0[8 * s2 + 7]);
                        const LAS unsigned char* vp = L + OFF_VT + (32 * vt + l31) * RS_T + (16 * s2 + 4 * hi) * 2;
                        const v2u x0 = *(const LAS v2u*)vp, x1 = *(const LAS v2u*)(vp + 16);
                        u32x4w aw; aw.x = x0.x; aw.y = x0.y; aw.z = x1.x; aw.w = x1.y;
                        oT = __builtin_amdgcn_mfma_f32_32x32x16_bf16(__builtin_bit_cast(bf16x8, aw), __builtin_bit_cast(bf16x8, pw), oT, 0, 0, 0);
                    }
                }
                float sq = 0.f;
#pragma unroll
                for (int jj = 0; jj < 16; ++jj) sq += oT[jj] * oT[jj];
                sq += __shfl_xor(sq, 32);
                if (hi == 0) ssq[vt * 64 + 32 * tt + l31] = sq;
                __syncthreads();
                const int tl = 32 * tt + l31;
                const float tot = (ssq[tl] + ssq[64 + tl]) + (ssq[128 + tl] + ssq[192 + tl]);
                const float rstd = 1.0f / sqrtf(tot * (1.0f / 128.0f) + RMS_EPS);
                const size_t rowt = row0 + ch * 64 + tl;
#pragma unroll
                for (int g4 = 0; g4 < 4; ++g4) {
                    const int v0 = 32 * vt + 8 * g4 + 4 * hi;
                    const f32x4 nv = *(const f32x4*)(nw + h * 128 + v0);
                    const v2u gt = *(const v2u*)(GT + rowt * 512 + h * 128 + v0);
                    v2u w; w.x = pk2(oT[4 * g4] * rstd * nv[0] * bflo(gt.x), oT[4 * g4 + 1] * rstd * nv[1] * bfhi(gt.x));
                    w.y = pk2(oT[4 * g4 + 2] * rstd * nv[2] * bflo(gt.y), oT[4 * g4 + 3] * rstd * nv[3] * bfhi(gt.y));
                    *(v2u*)(O + rowt * 1024 + h * 128 + v0) = w;
                }
            }
#pragma unroll
            for (int kt2 = 0; kt2 < 2; ++kt2) {
                const int kt = kt0 + kt2;
#pragma unroll
                for (int g4 = 0; g4 < 4; ++g4) { const f32x4 dv = *(const LAS f32x4*)(dvec + 32 * kt + 8 * g4 + 4 * hi);
                    acc[kt2][4 * g4] *= dv[0]; acc[kt2][4 * g4 + 1] *= dv[1]; acc[kt2][4 * g4 + 2] *= dv[2]; acc[kt2][4 * g4 + 3] *= dv[3]; }
#pragma unroll
                for (int ts = 0; ts < 4; ++ts) {
                    const bf16x8 a = *(const LAS bf16x8*)(L + OFF_KD + (32 * kt + l31) * RS_T + (16 * ts + 8 * hi) * 2);
                    const bf16x8 bb = *(const LAS bf16x8*)(L + OFF_VT + (32 * vt + l31) * RS_T + (16 * ts + 8 * hi) * 2);
                    acc[kt2] = __builtin_amdgcn_mfma_f32_32x32x16_bf16(a, bb, acc[kt2], 0, 0, 0);
                }
                if (MODE == 1) {
#pragma unroll
                    for (int g4 = 0; g4 < 4; ++g4) { v2u w; w.x = pk2(acc[kt2][4 * g4], acc[kt2][4 * g4 + 1]); w.y = pk2(acc[kt2][4 * g4 + 2], acc[kt2][4 * g4 + 3]);
                        *(LAS v2u*)(L + OFF_ST + (32 * vt + l31) * RS_C + (32 * kt + 8 * g4 + 4 * hi) * 2) = w; }
                }
            }
            __syncthreads();
        }
        if (MODE == 0) {
#pragma unroll
            for (int kt2 = 0; kt2 < 2; ++kt2)
#pragma unroll
                for (int g4 = 0; g4 < 4; ++g4) {
                    const int v = 32 * vt + l31, k0 = 32 * (kt0 + kt2) + 8 * g4 + 4 * hi;
                    *(f32x4*)(STATE + (size_t)item * 16384 + v * 128 + k0) = (f32x4){acc[kt2][4 * g4], acc[kt2][4 * g4 + 1], acc[kt2][4 * g4 + 2], acc[kt2][4 * g4 + 3]};
                }
            if (tq == 0) DV[item * 128 + c] = __expf(gtot);
        }
    }
}
__device__ __forceinline__ void hgrn_scan(float* STATE, const float* DV, int tid) {
    asm volatile("" : "+v"(tid));
    for (int e = blockIdx.x * 512 + tid; e < 8 * 16384; e += gridDim.x * 512) {
        const int bh = e >> 14, vk = e & 16383, k = vk & 127;
        float S = 0.f;
        for (int sc0 = 0; sc0 < 64; sc0 += 16) {
            float lv[16], dv[16];
#pragma unroll
            for (int i = 0; i < 16; ++i) { const size_t item = (size_t)bh * 64 + sc0 + i; lv[i] = STATE[item * 16384 + vk]; dv[i] = DV[item * 128 + k]; }
#pragma unroll
            for (int i = 0; i < 16; ++i) { const size_t item = (size_t)bh * 64 + sc0 + i; STATE[item * 16384 + vk] = S; S = dv[i] * S + lv[i]; }
        }
    }
}

__global__ void __launch_bounds__(512, 2) fwd_mega(Args args) {
    extern __shared__ __attribute__((aligned(16))) unsigned char lds[];
    cg::grid_group grid = cg::this_grid();
    LAS unsigned char* L = (LAS unsigned char*)lds;
    const int tid = threadIdx.x, lane = tid & 63, wave = __builtin_amdgcn_readfirstlane(tid >> 6);
    const int G = gridDim.x, gw = blockIdx.x * NWAVES + wave, NGW = G * NWAVES;
    unsigned char* ws = args.ws;
    const float* x_in = args.in[0];
    bf16* XB = (bf16*)(ws + WS_XB);
    bf16* SEGB = (bf16*)(ws + WS_A);
    bf16* QS = SEGB; bf16* VI = SEGB + 1 * (SEG_BYTES / 2); bf16* GT = SEGB + 2 * (SEG_BYTES / 2);
    bf16* AQ = SEGB + 3 * (SEG_BYTES / 2); bf16* AK = SEGB + 4 * (SEG_BYTES / 2); bf16* AV = SEGB + 5 * (SEG_BYTES / 2);
    float* LF = (float*)(ws + WS_LF);
    float* Y = (float*)(ws + WS_A);
    bf16* H = (bf16*)(ws + WS_A);
    bf16* O = (bf16*)(ws + WS_B);
    float* ORAW = (float*)(ws + WS_ORAW);
    float* Y2 = (float*)(ws + WS_B);
    float* out = args.out;

    volatile LAS unsigned* MISC = (volatile LAS unsigned*)(L + 131072);
    if (tid < 64) MISC[tid] = 0u;
    if (blockIdx.x == 0) { unsigned* bw = (unsigned*)(ws + WS_BAR); for (int i = tid; i < XCD_BAR_WORDS; i += 512) __hip_atomic_store(bw + i, 0u, __ATOMIC_RELAXED, __HIP_MEMORY_SCOPE_AGENT); }
    __syncthreads();
    {
        LAS float* scr = (LAS float*)(L + wave * 16384);
        for (int l = 0; l < DEPTH; ++l) {
            bf16* wl = (bf16*)(ws + WS_W + l * W_LAYER);
            constexpr int I_IN = (D / 64) * (NIN / 32), I_O = (D / 64) * (D / 32), I_1 = (D / 64) * (FF / 32), I_2 = (FF / 64) * (D / 32);
            for (int it = gw; it < I_IN + I_O + I_1 + I_2; it += NGW) {
                int r = it;
                if (r < I_IN) { p0_transpose_item(args.in[1] + (size_t)l * D * NIN, D, NIN, wl + W_IN / 2, scr, r, lane); continue; } r -= I_IN;
                if (r < I_O) { p0_transpose_item(args.in[2] + (size_t)l * D * D, D, D, wl + W_O / 2, scr, r, lane); continue; } r -= I_O;
                if (r < I_1) { p0_transpose_item(args.in[7] + (size_t)l * D * FF, D, FF, wl + W_1 / 2, scr, r, lane); continue; } r -= I_1;
                p0_transpose_item(args.in[8] + (size_t)l * FF * D, FF, D, wl + W_2 / 2, scr, r, lane);
            }
        }
        for (size_t i = (size_t)blockIdx.x * 512 + tid; i < (size_t)M * D / 4; i += (size_t)G * 512) {
            const f32x4 v = ((const f32x4*)x_in)[i]; v2u w; w.x = pk2(v.x, v.y); w.y = pk2(v.z, v.w); ((v2u*)XB)[i] = w; }
    }
    grid.sync();
    const XcdBarrier xbar = xcd_barrier_post((unsigned*)(ws + WS_BAR), MISC + 8);
#define GSYNC() xcd_barrier(xbar)

#ifndef REP_G
#define REP_G 1
#endif
#ifndef REP_M
#define REP_M 1
#endif
#ifndef REP_L
#define REP_L 1
#endif
#ifndef REP_S
#define REP_S 0
#endif
    for (int l = 0; l < DEPTH; ++l) {
        const bf16* wl = (const bf16*)(ws + WS_W + l * W_LAYER);
        const float* res0 = l == 0 ? x_in : out;
        for (int rep = 0; rep < REP_G; ++rep) {
            pg8::Gemm g{XB, wl + W_IN / 2, M, NIN, D}; pg8::StaticOrder S; { int bx = blockIdx.x, Gs = G; asm volatile("" : "+s"(bx), "+s"(Gs)); S.init(M, NIN, Gs, bx); }
            pg8::EpiInProj E{SEGB, LF, args.in[3], args.in[3] + HW, l};
            pg8::gemm_phase<pg8::EpiInProj, pg8::StaticOrder, true, true>(L, g, S, E);
            GSYNC();
        }
        for (int rep = 0; rep < REP_M; ++rep) {
            hgrn_pass<0>(QS, LF, VI, GT, args.in[4] + l * HW, ORAW, (float*)(ws + WS_DV), O, L, tid);
            attn_mfma(AQ, AK, AV, O, XB, (float*)(ws + WS_ML), L, tid);
            GSYNC();
        }
        hgrn_scan(ORAW, (const float*)(ws + WS_DV), tid);
        attn_merge(O, XB, (const float*)(ws + WS_ML), gw, NGW, lane);
        GSYNC();
        for (int rep = 0; rep < REP_M; ++rep) {
            hgrn_pass<1>(QS, LF, VI, GT, args.in[4] + l * HW, ORAW, (float*)(ws + WS_DV), O, L, tid);
            GSYNC();
        }
        for (int rep = 0; rep < REP_G; ++rep) {
            pg8::Gemm g{O, wl + W_O / 2, M, D, D}; pg8::StaticOrder S; { int bx = blockIdx.x, Gs = G; asm volatile("" : "+s"(bx), "+s"(Gs)); S.init(M, D, Gs, bx); }
            pg8::EpiResid E{res0, Y, ALPHA};
            pg8::gemm_phase<pg8::EpiResid, pg8::StaticOrder, true, true>(L, g, S, E);
            GSYNC();
        }
        for (int rep = 0; rep < REP_L; ++rep) {
            ln_rows(Y, out, XB, args.in[5] + l * D, args.in[6] + l * D, gw, NGW, lane);
            GSYNC();
        }
        for (int rep = 0; rep < REP_G; ++rep) {
            pg8::Gemm g{XB, wl + W_1 / 2, M, FF, D}; pg8::StaticOrder S; { int bx = blockIdx.x, Gs = G; asm volatile("" : "+s"(bx), "+s"(Gs)); S.init(M, FF, Gs, bx); }
            pg8::EpiSqRelu E{H};
            pg8::gemm_phase<pg8::EpiSqRelu, pg8::StaticOrder, true, true>(L, g, S, E);
            GSYNC();
        }
        for (int rep = 0; rep < REP_G; ++rep) {
            pg8::Gemm g{H, wl + W_2 / 2, M, D, FF}; pg8::StaticOrder S; { int bx = blockIdx.x, Gs = G; asm volatile("" : "+s"(bx), "+s"(Gs)); S.init(M, D, Gs, bx); }
            pg8::EpiResid E{out, Y2, ALPHA};
            pg8::gemm_phase<pg8::EpiResid, pg8::StaticOrder, true, true>(L, g, S, E);
            GSYNC();
        }
        for (int rep = 0; rep < REP_L; ++rep) {
            ln_rows(Y2, out, XB, args.in[9] + l * D, args.in[10] + l * D, gw, NGW, lane);
            if (l + 1 < DEPTH || rep + 1 < REP_L) GSYNC();
        }
    }
    for (int rep = 0; rep < REP_S; ++rep) GSYNC();
}

extern "C" void kernel_launch(void* const* d_in, const int* in_sizes, int n_in, void* d_out, int out_size, void* d_ws, size_t ws_size, hipStream_t stream) {
    static int grid = 0;
    if (grid == 0) {
        if (n_in != 11 || in_sizes[0] != M * D || out_size != M * D || ws_size < WS_END) { fprintf(stderr, "kernel_launch: unexpected shapes / workspace (%d inputs, ws %zu)\n", n_in, ws_size); grid = -1; return; }
        int dev = 0, cus = 0, per_cu = 0;
        hipGetDevice(&dev); hipDeviceGetAttribute(&cus, hipDeviceAttributeMultiprocessorCount, dev);
        hipFuncSetAttribute((const void*)fwd_mega, hipFuncAttributeMaxDynamicSharedMemorySize, LDS_BYTES);
        hipOccupancyMaxActiveBlocksPerMultiprocessor(&per_cu, (const void*)fwd_mega, 512, LDS_BYTES);
        if (per_cu < 1) per_cu = 1;
        grid = cus;
        (void)hipGetLastError();
    }
    if (grid < 0) return;
    Args a{};
    for (int i = 0; i < 11; ++i) a.in[i] = (const float*)d_in[i];
    a.out = (float*)d_out; a.ws = (unsigned char*)d_ws;
    void* kargs[] = {&a};
    hipError_t e = hipLaunchCooperativeKernel((const void*)fwd_mega, dim3(grid), dim3(512), kargs, LDS_BYTES, stream);
    if (e != hipSuccess) fprintf(stderr, "cooperative launch failed: %s (grid %d)\n", hipGetErrorString(e), grid);
}
```
